# Optimizing an MI355X kernel written in HIP

```python
import math
import jax, jax.numpy as jnp
from jax import lax
import numpy as np

D_MODEL = 1024
BATCH = 8
SEQ = 4096
DEPTH = 4
DEC_BATCH = 16
DEC_SEQ = 2048
PAST_LEN = 128

N_MIXERS = 3
D_FF = 2816
NORM_EPS = 1e-6

HG_HEADS = 8
HG_KDIM = D_MODEL // HG_HEADS
HG_VDIM = D_MODEL // HG_HEADS
HG_CHUNK = 64

SW_HEADS = 16
SW_KV_HEADS = 4
SW_HEAD_DIM = D_MODEL // SW_HEADS
SW_WINDOW = 128
SW_BLOCK = 128
ROPE_THETA = 500000.0
ROPE_DIMS = SW_HEAD_DIM // 4

GRID_W = 64
NA_HEADS = 16
NA_HEAD_DIM = D_MODEL // NA_HEADS
NA_MAX_ROWS = 8
NA_COLS = 16
NA_QCOLS = 16
NA_KSPAN = NA_QCOLS + NA_COLS

N_LAYERS_A = len(range(0, DEPTH, N_MIXERS))
N_LAYERS_B = len(range(1, DEPTH, N_MIXERS))
N_LAYERS_C = len(range(2, DEPTH, N_MIXERS))

kernel_name = "hybrid_hgrn2_swa_natten_macaron_encoder"

F32 = jnp.float32


def rmsnorm(x, g):
    xf = x.astype(F32)
    y = xf * lax.rsqrt(jnp.mean(xf * xf, axis=-1, keepdims=True) + NORM_EPS)
    return (y * g.astype(F32)).astype(x.dtype)


def swiglu_ffn(x, w1, w2):
    gate, up = jnp.split(x @ w1, 2, axis=-1)
    return (jax.nn.silu(gate) * up) @ w2


def gla_chunk_scan(q, k, v, logf):
    B, T, H, K = q.shape
    V = v.shape[-1]
    C = HG_CHUNK
    N = T // C

    def to_chunks(a):
        return jnp.moveaxis(a.reshape(B, N, C, H, a.shape[-1]), 1, 0)

    qc, kc, vc, fc = to_chunks(q), to_chunks(k), to_chunks(v), to_chunks(logf)
    incl = jnp.asarray(np.tril(np.ones((C, C), dtype=bool)))

    def step(S, inp):
        qi, ki, vi, fi = inp
        qf, kf, vf = qi.astype(F32), ki.astype(F32), vi.astype(F32)
        b = jnp.cumsum(fi.astype(F32), axis=1)
        o_inter = jnp.einsum('bchk,bhkv->bchv', qf * jnp.exp(b), S)
        rel = b[:, :, None] - b[:, None, :]
        rel = jnp.where(incl[None, :, :, None, None], rel, -jnp.inf)
        A = jnp.einsum('bthk,btshk,bshk->bhts', qf, jnp.exp(rel), kf)
        o_intra = jnp.einsum('bhts,bshv->bthv', A, vf)
        b_end = b[:, -1]
        k_dec = kf * jnp.exp(b_end[:, None] - b)
        S_new = jnp.exp(b_end)[..., None] * S + jnp.einsum('bchk,bchv->bhkv', k_dec, vf)
        return S_new, (o_inter + o_intra).astype(v.dtype)

    S0 = jnp.zeros((B, H, K, V), F32)
    _, o = lax.scan(step, S0, (qc, kc, vc, fc))
    return jnp.moveaxis(o, 0, 1).reshape(B, T, H, V)


def hgrn2_mixer(x, w_in, w_o, g_norm, lb):
    B, T, _ = x.shape
    H, K, V = HG_HEADS, HG_KDIM, HG_VDIM
    q, i, g, f_fw, f_bw = jnp.split(x @ w_in, 5, axis=-1)
    q = q.reshape(B, T, H, K)
    i = i.reshape(B, T, H, V)

    def gates(fpre, lbd):
        lbd = lbd.astype(F32)
        f = lbd + (1.0 - lbd) * jax.nn.sigmoid(fpre.astype(F32))
        logf = jnp.log(f).reshape(B, T, H, K)
        k = (1.0 - f).reshape(B, T, H, K).astype(x.dtype)
        return k, logf

    k_f, logf_f = gates(f_fw, lb[0])
    k_b, logf_b = gates(f_bw, lb[1])
    o_fwd = gla_chunk_scan(q, k_f, i, logf_f)
    rev = lambda a: jnp.flip(a, axis=1)
    o_bwd = rev(gla_chunk_scan(rev(q), rev(k_b), rev(i), rev(logf_b)))
    o = (o_fwd + o_bwd).astype(F32)
    o = o * lax.rsqrt(jnp.mean(o * o, axis=-1, keepdims=True) + NORM_EPS)
    o = o * g_norm.astype(F32).reshape(H, V)
    o = o.reshape(B, T, H * V).astype(x.dtype) * jax.nn.silu(g)
    return o @ w_o


def rope_partial(x):
    T = x.shape[1]
    half = ROPE_DIMS // 2
    inv = jnp.exp(-jnp.arange(half, dtype=F32) * (2.0 / ROPE_DIMS) * math.log(ROPE_THETA))
    ang = jnp.arange(T, dtype=F32)[:, None] * inv[None, :]
    cos = jnp.cos(ang)[None, :, None, :]
    sin = jnp.sin(ang)[None, :, None, :]
    xr = x[..., :ROPE_DIMS].astype(F32)
    x1, x2 = xr[..., :half], xr[..., half:]
    rot = jnp.concatenate([x1 * cos - x2 * sin, x2 * cos + x1 * sin], axis=-1)
    return jnp.concatenate([rot.astype(x.dtype), x[..., ROPE_DIMS:]], axis=-1)


def window_gqa_mixer(x, w_qkv, w_o, sinks):
    B, T, _ = x.shape
    Hq, Hk, d = SW_HEADS, SW_KV_HEADS, SW_HEAD_DIM
    G = Hq // Hk
    L = SW_BLOCK
    nb = T // L
    q, k, v = jnp.split(x @ w_qkv, [Hq * d, Hq * d + Hk * d], axis=-1)
    q = rope_partial(q.reshape(B, T, Hq, d))
    k = rope_partial(k.reshape(B, T, Hk, d))
    v = v.reshape(B, T, Hk, d)
    pad = ((0, 0), (L, L), (0, 0), (0, 0))
    kb = jnp.pad(k, pad).reshape(B, nb + 2, L, Hk, d)
    vb = jnp.pad(v, pad).reshape(B, nb + 2, L, Hk, d)
    kband = jnp.concatenate([kb[:, :-2], kb[:, 1:-1], kb[:, 2:]], axis=2)
    vband = jnp.concatenate([vb[:, :-2], vb[:, 1:-1], vb[:, 2:]], axis=2)
    qb = q.reshape(B, nb, L, Hk, G, d)
    s = jnp.einsum('bnqhgd,bnkhd->bnhgqk', qb, kband).astype(F32) * (d ** -0.5)
    qpos = np.arange(nb)[:, None, None] * L + np.arange(L)[None, :, None]
    kpos = (np.arange(nb)[:, None, None] - 1) * L + np.arange(3 * L)[None, None, :]
    mask = (np.abs(kpos - qpos) <= SW_WINDOW) & (kpos >= 0) & (kpos < T)
    s = jnp.where(jnp.asarray(mask)[None, :, None, None], s, -jnp.inf)
    sink = sinks.astype(F32).reshape(Hk, G)[None, None, :, :, None, None]
    m = jnp.maximum(jnp.max(s, axis=-1, keepdims=True), sink)
    p = jnp.exp(s - m)
    denom = jnp.sum(p, axis=-1, keepdims=True) + jnp.exp(sink - m)
    o = jnp.einsum('bnhgqk,bnkhd->bnqhgd', (p / denom).astype(v.dtype), vband)
    return o.reshape(B, T, Hq * d) @ w_o


def neighbourhood_mixer(x, w_qkv, w_o, rpb):
    B, T, _ = x.shape
    H, d = NA_HEADS, NA_HEAD_DIM
    rows = T // GRID_W
    kr = min(NA_MAX_ROWS, rows)
    q, k, v = jnp.split(x @ w_qkv, 3, axis=-1)
    qg = q.reshape(B, rows, GRID_W, H, d)
    kg = k.reshape(B, rows, GRID_W, H, d)
    vg = v.reshape(B, rows, GRID_W, H, d)
    nqb = GRID_W // NA_QCOLS
    col_start = np.clip(np.arange(nqb) * NA_QCOLS - NA_COLS // 2, 0, GRID_W - NA_KSPAN)
    col_idx = col_start[:, None] + np.arange(NA_KSPAN)[None, :]
    qcol = np.arange(nqb)[:, None] * NA_QCOLS + np.arange(NA_QCOLS)[None, :]
    cs = np.clip(qcol - NA_COLS // 2, 0, GRID_W - NA_COLS)
    kcol = col_idx[:, None, :]
    col_valid = (kcol >= cs[..., None]) & (kcol < cs[..., None] + NA_COLS)
    dc = np.clip(kcol - qcol[..., None], -(NA_COLS - 1), NA_COLS - 1) + NA_COLS - 1
    bias_c = rpb.astype(F32)[:, :, dc]
    bias_c = jnp.where(jnp.asarray(col_valid)[None, None], bias_c, -jnp.inf)
    scale = d ** -0.5

    def row_block(r):
        rs = jnp.clip(r - kr // 2, 0, rows - kr)
        k_rows = lax.dynamic_slice_in_dim(kg, rs, kr, axis=1)
        v_rows = lax.dynamic_slice_in_dim(vg, rs, kr, axis=1)
        k_blk = k_rows[:, :, col_idx]
        v_blk = v_rows[:, :, col_idx]
        q_row = lax.dynamic_index_in_dim(qg, r, axis=1, keepdims=False)
        q_row = q_row.reshape(B, nqb, NA_QCOLS, H, d)
        s = jnp.einsum('bjqhd,bajchd->bhjqac', q_row, k_blk).astype(F32) * scale
        dr = rs + jnp.arange(kr) - r + NA_MAX_ROWS - 1
        bias = jnp.transpose(bias_c[:, dr], (0, 2, 3, 1, 4))
        s = s + bias[None]
        shp = s.shape
        p = jax.nn.softmax(s.reshape(shp[:4] + (kr * NA_KSPAN,)), axis=-1).reshape(shp)
        o = jnp.einsum('bhjqac,bajchd->bjqhd', p.astype(v.dtype), v_blk)
        return o.reshape(B, GRID_W, H * d)

    o = lax.map(row_block, jnp.arange(rows))
    o = jnp.moveaxis(o, 0, 1).reshape(B, T, H * d)
    return o @ w_o


def run_trunk(x, norm_g, final_norm_g, ffn_w1, ffn_w2, hg_w_in, hg_w_o, hg_g_norm, lb_all,
              sw_w_qkv, sw_w_o, sw_sinks, na_w_qkv, na_w_o, na_rpb):
    ia = ib = ic = 0
    for li in range(DEPTH):
        x = x + 0.5 * swiglu_ffn(rmsnorm(x, norm_g[li, 0]), ffn_w1[li, 0], ffn_w2[li, 0])
        h = rmsnorm(x, norm_g[li, 1])
        kind = li % N_MIXERS
        if kind == 0:
            mix = hgrn2_mixer(h, hg_w_in[ia], hg_w_o[ia], hg_g_norm[ia], lb_all[:, li])
            ia += 1
        elif kind == 1:
            mix = window_gqa_mixer(h, sw_w_qkv[ib], sw_w_o[ib], sw_sinks[ib])
            ib += 1
        else:
            mix = neighbourhood_mixer(h, na_w_qkv[ic], na_w_o[ic], na_rpb[ic])
            ic += 1
        x = x + mix
        x = x + 0.5 * swiglu_ffn(rmsnorm(x, norm_g[li, 2]), ffn_w1[li, 1], ffn_w2[li, 1])
    return rmsnorm(x, final_norm_g)


def setup_inputs(seed: int = 0) -> dict:
    key = jax.random.key(seed)
    ks = jax.random.split(key, 20)
    D = D_MODEL
    nrm = lambda k, shape, s: jax.random.normal(k, shape, F32) * s
    return {
        "x_prompt": nrm(ks[0], (BATCH, SEQ, D), 1.0),
        "x_sample": nrm(ks[1], (DEC_BATCH, DEC_SEQ, D), 1.0),
        "norm_g": 1.0 + nrm(ks[2], (DEPTH, 3, D), 0.02),
        "final_norm_g": 1.0 + nrm(ks[3], (D,), 0.02),
        "ffn_w1": nrm(ks[4], (DEPTH, 2, D, 2 * D_FF), D ** -0.5),
        "ffn_w2": nrm(ks[5], (DEPTH, 2, D_FF, D), D_FF ** -0.5),
        "hg_w_in": nrm(ks[6], (N_LAYERS_A, D, 5 * D), D ** -0.5),
        "hg_w_o": nrm(ks[7], (N_LAYERS_A, HG_HEADS * HG_VDIM, D), (HG_HEADS * HG_VDIM) ** -0.5),
        "hg_g_norm": 1.0 + nrm(ks[8], (N_LAYERS_A, HG_HEADS * HG_VDIM), 0.02),
        "hg_lb": nrm(ks[9], (2, DEPTH, HG_HEADS * HG_KDIM), 0.5),
        "sw_w_qkv": nrm(ks[10], (N_LAYERS_B, D, (SW_HEADS + 2 * SW_KV_HEADS) * SW_HEAD_DIM), D ** -0.5),
        "sw_w_o": nrm(ks[11], (N_LAYERS_B, SW_HEADS * SW_HEAD_DIM, D), (SW_HEADS * SW_HEAD_DIM) ** -0.5),
        "sw_sinks": nrm(ks[12], (N_LAYERS_B, SW_HEADS), 0.5),
        "na_w_qkv": nrm(ks[13], (N_LAYERS_C, D, 3 * NA_HEADS * NA_HEAD_DIM), D ** -0.5),
        "na_w_o": nrm(ks[14], (N_LAYERS_C, NA_HEADS * NA_HEAD_DIM, D), (NA_HEADS * NA_HEAD_DIM) ** -0.5),
        "na_rpb": nrm(ks[15], (N_LAYERS_C, NA_HEADS, 2 * NA_MAX_ROWS - 1, 2 * NA_COLS - 1), 0.1),
    }


def reference(x_prompt, x_sample, norm_g, final_norm_g, ffn_w1, ffn_w2, hg_w_in, hg_w_o,
              hg_g_norm, hg_lb, sw_w_qkv, sw_w_o, sw_sinks, na_w_qkv, na_w_o, na_rpb):
    lb_sm = jax.nn.softmax(hg_lb.astype(F32), axis=1)
    lb_all = jnp.cumsum(lb_sm, axis=1) - lb_sm[:, :1]
    y_prompt = run_trunk(x_prompt, norm_g, final_norm_g, ffn_w1, ffn_w2, hg_w_in, hg_w_o,
                         hg_g_norm, lb_all, sw_w_qkv, sw_w_o, sw_sinks, na_w_qkv, na_w_o, na_rpb)
    y_sample = run_trunk(x_sample, norm_g, final_norm_g, ffn_w1, ffn_w2, hg_w_in, hg_w_o,
                         hg_g_norm, lb_all, sw_w_qkv, sw_w_o, sw_sinks, na_w_qkv, na_w_o, na_rpb)
    return (y_prompt, y_sample)
```

```cpp
#include <hip/hip_runtime.h>
#include <hip/hip_cooperative_groups.h>
#include <cstdio>
#include <cstdint>
#include <cstring>
#include <cmath>
namespace cg = cooperative_groups;
namespace pg8 {
#define PG8_LAS __attribute__((address_space(3)))
typedef unsigned short bf16_t;
typedef short bf16x8 __attribute__((ext_vector_type(8)));
typedef float f32x4 __attribute__((ext_vector_type(4)));
typedef unsigned u32x4 __attribute__((ext_vector_type(4)));
constexpr int BM = 256, BK = 64, HALF = 128, HTB = HALF * BK * 2  , STAGE_BYTES = 8 * HTB, NXCD = 8, WGM = 8;

__host__ __device__ __forceinline__ int lds_byte(int r, int c) { const int st = (r >> 4) * 2 + (c >> 5), rr = r & 15, cc = c & 31, ob = rr * 64 + cc * 2; return st * 1024 + (ob ^ (((ob >> 9) & 1) << 5)); }
__host__ __device__ __forceinline__ void stage_rc(int b, int& R, int& C) { const int st = b / 1024, sb = b % 1024, swz = sb ^ (((sb >> 9) & 1) << 5); R = (st >> 1) * 16 + swz / 64; C = (st & 1) * 32 + (swz % 64) / 2; }
__host__ __device__ __forceinline__ int perm32(int rho) { const int n = rho >> 4, i = rho & 15; return 8 * (i >> 2) + 4 * n + (i & 3); }

struct Unit { int pm, pn; };
struct Gemm { const bf16_t* A; const bf16_t* Bt; int M, N, K; };

struct StaticOrder {
    int nM, nN, nwg, G, c;
    __host__ __device__ void init(int M, int N, int G_, int c_) { nM = M / BM; nN = N / BM; nwg = nM * nN; G = G_; c = c_; }
    __host__ __device__ bool next(int i, Unit& u) const {
        const long L = (long)i * G + c; if (L >= nwg) return false;
        int wgid = (int)L; { const int q = nwg / NXCD, r = nwg % NXCD, xcd = wgid % NXCD, off = wgid / NXCD; wgid = (xcd < r ? xcd * (q + 1) : r * (q + 1) + (xcd - r) * q) + off; }
        const int nig = WGM * nN, gid = wgid / nig, fm = gid * WGM, gsz = (nM - fm) < WGM ? (nM - fm) : WGM;
        u.pm = fm + ((wgid % nig) % gsz); u.pn = (wgid % nig) / gsz; return true;
    }
    __device__ __forceinline__ void a_ready(const Unit&) const {}
    __device__ __forceinline__ void done(const Unit&) const {}
};

typedef float f32x2c __attribute__((ext_vector_type(2))); typedef __bf16 bf16x2c __attribute__((ext_vector_type(2)));
__device__ __forceinline__ unsigned cvt_pk_bf16(float lo, float hi) { const f32x2c v = {lo, hi}; const bf16x2c b = __builtin_convertvector(v, bf16x2c); return __builtin_bit_cast(unsigned, b); }
typedef float f32x2 __attribute__((ext_vector_type(2)));
__device__ __forceinline__ float fast_sigmoid(float x) { return __builtin_amdgcn_rcpf(1.0f + __expf(-x)); }
__device__ __forceinline__ float rstd_row(const float* part, int row) { const f32x4* p = (const f32x4*)(part + (size_t)row * 16); const f32x4 a = p[0], b = p[1], c = p[2], d = p[3];
    const float ss = ((a[0] + a[1]) + (a[2] + a[3])) + ((b[0] + b[1]) + (b[2] + b[3])) + ((c[0] + c[1]) + (c[2] + c[3])) + ((d[0] + d[1]) + (d[2] + d[3]));
    return __builtin_amdgcn_rsqf(ss * (1.0f / 1024.0f) + 1e-6f); }
struct EpiSwiglu {
    static constexpr bool PERM = true, AFTER_DRAIN = false;
    bf16_t* H; int ldh; const float* ssq;
    __device__ __forceinline__ void operator()(const f32x4 (&acc)[2][2][4][2], const Unit& u, int wr, int wc, int fr, int fq) const {
        const int row0 = u.pm * BM + wr * 64 + fr, col0 = u.pn * HALF + wc * 32 + 8 * fq;
#pragma unroll
        for (int ai = 0; ai < 2; ++ai)
#pragma unroll
            for (int m = 0; m < 4; ++m) {
                const int row = row0 + ai * HALF + m * 16;
                bf16_t* rowp = H + (size_t)row * ldh + col0;
                const float rs = rstd_row(ssq, row);
                float o[8];
#pragma unroll
                for (int n = 0; n < 2; ++n)
#pragma unroll
                    for (int e = 0; e < 4; ++e) { const float g = acc[ai][0][m][n][e] * rs, up = acc[ai][1][m][n][e] * rs; o[4 * n + e] = g * fast_sigmoid(g) * up; }
                u32x4 w; w.x = cvt_pk_bf16(o[0], o[1]); w.y = cvt_pk_bf16(o[2], o[3]); w.z = cvt_pk_bf16(o[4], o[5]); w.w = cvt_pk_bf16(o[6], o[7]);
                *(u32x4*)rowp = w;
            }
    }
};
struct EpiResid {
    static constexpr bool PERM = true, AFTER_DRAIN = false;
    float* X; int ldx; float scale; bf16_t* XN; float* ssq;
    __device__ __forceinline__ void operator()(const f32x4 (&acc)[2][2][4][2], const Unit& u, int wr, int wc, int fr, int fq) const {
        const int row0 = u.pm * BM + wr * 64 + fr, col0 = u.pn * BM + wc * 32 + 8 * fq;
#pragma unroll
        for (int ai = 0; ai < 2; ++ai)
#pragma unroll
            for (int m = 0; m < 4; ++m) {
                const int row = row0 + ai * HALF + m * 16;
                float* rowp = X + (size_t)row * ldx + col0;
                f32x4 v[2][2]; float part = 0.f;
#pragma unroll
                for (int bj = 0; bj < 2; ++bj)
#pragma unroll
                    for (int n = 0; n < 2; ++n) { f32x4* q = (f32x4*)(rowp + bj * HALF + 4 * n); const f32x4 t = *q + acc[ai][bj][m][n] * scale; *q = t; v[bj][n] = t;
                        part += (t[0] * t[0] + t[1] * t[1]) + (t[2] * t[2] + t[3] * t[3]); }
                if (XN) {
#pragma unroll
                    for (int bj = 0; bj < 2; ++bj) { u32x4 w; w.x = cvt_pk_bf16(v[bj][0][0], v[bj][0][1]); w.y = cvt_pk_bf16(v[bj][0][2], v[bj][0][3]); w.z = cvt_pk_bf16(v[bj][1][0], v[bj][1][1]); w.w = cvt_pk_bf16(v[bj][1][2], v[bj][1][3]);
                        *(u32x4*)(XN + (size_t)row * 1024 + col0 + bj * HALF) = w; }
                    part += __shfl_xor(part, 16); part += __shfl_xor(part, 32);
                    if (fq == 0) ssq[(size_t)row * 16 + u.pn * 4 + wc] = part;
                }
            }
    }
};
template <bool COLS> struct EpiStore {
    static constexpr bool PERM = true, AFTER_DRAIN = false;
    bf16_t* O; size_t ldo; const float* ssq;
    __device__ __forceinline__ void operator()(const f32x4 (&acc)[2][2][4][2], const Unit& u, int wr, int wc, int fr, int fq) const {
        const int row0 = u.pm * BM + wr * 64 + fr, col0 = u.pn * BM + wc * 32 + 8 * fq;
        f32x4 cs[2][2];
        if (COLS) {
#pragma unroll
            for (int bj = 0; bj < 2; ++bj)
#pragma unroll
                for (int n = 0; n < 2; ++n) { const int c = col0 + bj * HALF + 4 * n; cs[bj][n] = (f32x4){rstd_row(ssq, c), rstd_row(ssq, c + 1), rstd_row(ssq, c + 2), rstd_row(ssq, c + 3)}; }
        }
#pragma unroll
        for (int ai = 0; ai < 2; ++ai)
#pragma unroll
            for (int m = 0; m < 4; ++m) {
                const int row = row0 + ai * HALF + m * 16;
                bf16_t* rowp = O + (size_t)row * ldo + col0;
                const float rs = COLS ? 1.0f : rstd_row(ssq, row);
#pragma unroll
                for (int bj = 0; bj < 2; ++bj) { const f32x4 v0 = COLS ? acc[ai][bj][m][0] * cs[bj][0] : acc[ai][bj][m][0] * rs, v1 = COLS ? acc[ai][bj][m][1] * cs[bj][1] : acc[ai][bj][m][1] * rs;
                    u32x4 w; w.x = cvt_pk_bf16(v0[0], v0[1]); w.y = cvt_pk_bf16(v0[2], v0[3]); w.z = cvt_pk_bf16(v1[0], v1[1]); w.w = cvt_pk_bf16(v1[2], v1[3]);
                    *(u32x4*)(rowp + bj * HALF) = w; }
            }
    }
};
__device__ __forceinline__ unsigned pk_f16(float a, float b) { const _Float16 ha = (_Float16)a, hb = (_Float16)b; return (unsigned)__builtin_bit_cast(unsigned short, ha) | ((unsigned)__builtin_bit_cast(unsigned short, hb) << 16); }
struct EpiHg {
    static constexpr bool PERM = true, AFTER_DRAIN = false;
    bf16_t* O; const float* lb; const float* ssq;
    __device__ __forceinline__ void operator()(const f32x4 (&acc)[2][2][4][2], const Unit& u, int wr, int wc, int fr, int fq) const {
        const int row0 = u.pm * BM + wr * 64 + fr, col0 = u.pn * BM + wc * 32 + 8 * fq;
        const bool gate = (u.pn >= 12);
        f32x4 lbv[2][2];
#pragma unroll
        for (int bj = 0; bj < 2; ++bj)
#pragma unroll
            for (int n = 0; n < 2; ++n) lbv[bj][n] = gate ? *(const f32x4*)(lb + (col0 - 3072) + bj * HALF + 4 * n) : (f32x4){0.f, 0.f, 0.f, 0.f};
#pragma unroll
        for (int ai = 0; ai < 2; ++ai)
#pragma unroll
            for (int m = 0; m < 4; ++m) {
                const int row = row0 + ai * HALF + m * 16;
                bf16_t* rowp = O + (size_t)row * 5120 + col0;
                const float rs = rstd_row(ssq, row);
#pragma unroll
                for (int bj = 0; bj < 2; ++bj) { const f32x4 v0 = acc[ai][bj][m][0] * rs, v1 = acc[ai][bj][m][1] * rs;
                    u32x4 w;
                    if (gate) {
                        float o[8];
#pragma unroll
                        for (int e = 0; e < 4; ++e) { const float l0 = lbv[bj][0][e], l1 = lbv[bj][1][e];
                            o[e] = __logf(l0 + (1.0f - l0) * fast_sigmoid(v0[e])); o[4 + e] = __logf(l1 + (1.0f - l1) * fast_sigmoid(v1[e])); }
                        w.x = pk_f16(o[0], o[1]); w.y = pk_f16(o[2], o[3]); w.z = pk_f16(o[4], o[5]); w.w = pk_f16(o[6], o[7]);
                    } else { w.x = cvt_pk_bf16(v0[0], v0[1]); w.y = cvt_pk_bf16(v0[2], v0[3]); w.z = cvt_pk_bf16(v1[0], v1[1]); w.w = cvt_pk_bf16(v1[2], v1[3]); }
                    *(u32x4*)(rowp + bj * HALF) = w; }
            }
    }
};
template <class Epi, class Sched, bool ALIGN_EPI = false, bool SP2 = false>
__device__ __forceinline__ void gemm_phase(PG8_LAS unsigned char* lds, const Gemm g, const Sched& S, const Epi& E, const int tid) {
    const int wid = __builtin_amdgcn_readfirstlane(tid >> 6), lane = tid & 63, wr = wid >> 2, wc = wid & 3, fr = lane & 15, fq = lane >> 4;
    const int K = g.K, nt = K / BK;
    unsigned voffA[2], voffB[2];
#pragma unroll
    for (int i = 0; i < 2; ++i) { int R, C; stage_rc(tid * 16 + i * 8192, R, C); const int Rb = Epi::PERM ? ((R & ~31) + perm32(R & 31)) : R;
        voffA[i] = (unsigned)(R * K + C) * 2u; voffB[i] = (unsigned)(Rb * K + C) * 2u; }
    const size_t kstep = (size_t)(BK * 2);
    const size_t hstep = (size_t)HALF * K * 2;
    const size_t tstep = 2 * hstep;
    const unsigned ldsw = (unsigned)wid * 1024u;
    const int aoff = lds_byte(wr * 64 + fr, fq * 8), boff = lds_byte(wc * 32 + fr, fq * 8);
#define PG8_SA(b, h) (((b) * 2 + (h)) * HTB)
#define PG8_SB(b, h) ((4 + (b) * 2 + (h)) * HTB)
#define PG8_STAGE(bufoff, gbase, voff) do { _Pragma("unroll") for (int _i = 0; _i < 2; ++_i) \
        __builtin_amdgcn_global_load_lds((const unsigned*)((const char*)(gbase) + (voff)[_i]), (PG8_LAS unsigned*)(lds + (bufoff) + ldsw + _i * 8192), 16, 0, 0); } while (0)
#define PG8_LDA(dst, b, h) do { _Pragma("unroll") for (int m = 0; m < 4; ++m) _Pragma("unroll") for (int k = 0; k < 2; ++k) dst[m][k] = *(const PG8_LAS bf16x8*)(lds + PG8_SA(b, h) + aoff + m * 2048 + k * 1024); } while (0)
#define PG8_LDB(dst, b, h) do { _Pragma("unroll") for (int n = 0; n < 2; ++n) _Pragma("unroll") for (int k = 0; k < 2; ++k) dst[n][k] = *(const PG8_LAS bf16x8*)(lds + PG8_SB(b, h) + boff + n * 2048 + k * 1024); } while (0)
#define PG8_MMA(ai, bj, At, Bt) do { __builtin_amdgcn_s_setprio(1); _Pragma("unroll") for (int m = 0; m < 4; ++m) _Pragma("unroll") for (int n = 0; n < 2; ++n) _Pragma("unroll") for (int k = 0; k < 2; ++k) \
        acc[ai][bj][m][n] = __builtin_amdgcn_mfma_f32_16x16x32_bf16(Bt[n][k], At[m][k], acc[ai][bj][m][n], 0, 0, 0); __builtin_amdgcn_s_setprio(0); } while (0)
#define PG8_WAIT_V(n) asm volatile("s_waitcnt vmcnt(" #n ")" ::: "memory")
#define PG8_WAIT_L(n) asm volatile("s_waitcnt lgkmcnt(" #n ")" ::: "memory")
#define PG8_BAR __builtin_amdgcn_s_barrier()
#define PG8_SCHED __builtin_amdgcn_sched_barrier(0)
    Unit cur, nxt; int ui = 0;
    if (!S.next(0, cur)) return;
    f32x4 acc[2][2][4][2];
#pragma unroll
    for (int a = 0; a < 2; ++a)
#pragma unroll
        for (int b = 0; b < 2; ++b)
#pragma unroll
            for (int m = 0; m < 4; ++m)
#pragma unroll
                for (int n = 0; n < 2; ++n) acc[a][b][m][n] = (f32x4){0.f, 0.f, 0.f, 0.f};
    bf16x8 At[4][2], B0[2][2], B1[2][2];
    const char* cA = (const char*)g.A + (size_t)cur.pm * tstep; const char* cB = (const char*)g.Bt + (size_t)cur.pn * tstep;
    S.a_ready(cur);
    if constexpr (SP2) {
        PG8_STAGE(PG8_SB(0, 0), cB, voffB); PG8_STAGE(PG8_SB(0, 1), cB + hstep, voffB); PG8_STAGE(PG8_SA(0, 0), cA, voffA); PG8_STAGE(PG8_SA(0, 1), cA + hstep, voffA);
        if (wr == 1) PG8_BAR;
        PG8_WAIT_V(2); PG8_BAR;
        PG8_STAGE(PG8_SB(1, 0), cB + kstep, voffB); PG8_STAGE(PG8_SA(1, 0), cA + kstep, voffA); PG8_STAGE(PG8_SB(1, 1), cB + hstep + kstep, voffB);
        PG8_WAIT_V(6); PG8_BAR;
    } else {
        PG8_STAGE(PG8_SB(0, 0), cB, voffB); PG8_STAGE(PG8_SA(0, 0), cA, voffA); PG8_STAGE(PG8_SB(0, 1), cB + hstep, voffB); PG8_STAGE(PG8_SA(0, 1), cA + hstep, voffA);
        if (wr == 1) PG8_BAR;
        PG8_WAIT_V(4); PG8_BAR;
        PG8_STAGE(PG8_SB(1, 0), cB + kstep, voffB); PG8_STAGE(PG8_SA(1, 0), cA + kstep, voffA); PG8_STAGE(PG8_SB(1, 1), cB + hstep + kstep, voffB);
        PG8_WAIT_V(6); PG8_BAR;
    }
    for (;;) {
        const bool has_next = S.next(ui + 1, nxt);
        const char* nA = has_next ? (const char*)g.A + (size_t)nxt.pm * tstep : cA; const char* nB = has_next ? (const char*)g.Bt + (size_t)nxt.pn * tstep : cB;
        for (int t = 0; t < nt; t += 2) {
            const bool last = (t == nt - 2);
            const char* a1 = cA + (size_t)(t + 1) * kstep;
            const char* a2 = last ? nA : cA + (size_t)(t + 2) * kstep; const char* b2 = last ? nB : cB + (size_t)(t + 2) * kstep;
            const char* a3 = a2 + kstep; const char* b3 = b2 + kstep;
            if (last && has_next) S.a_ready(nxt);
            if constexpr (SP2) {
            PG8_LDB(B0, 0, 0); PG8_LDB(B1, 0, 1); PG8_SCHED; PG8_LDA(At, 0, 0); PG8_STAGE(PG8_SA(1, 1), a1 + hstep, voffA);
            PG8_WAIT_V(8); PG8_WAIT_L(0); PG8_BAR; PG8_MMA(0, 0, At, B0); PG8_MMA(0, 1, At, B1); PG8_BAR; PG8_SCHED;
            PG8_LDA(At, 0, 1); PG8_STAGE(PG8_SB(0, 0), b2, voffB); PG8_STAGE(PG8_SB(0, 1), b2 + hstep, voffB); PG8_STAGE(PG8_SA(0, 0), a2, voffA);
            PG8_WAIT_V(8); PG8_WAIT_L(0); PG8_BAR; PG8_MMA(1, 0, At, B0); PG8_MMA(1, 1, At, B1); PG8_BAR; PG8_SCHED;
            PG8_LDB(B0, 1, 0); PG8_LDB(B1, 1, 1); PG8_SCHED; PG8_LDA(At, 1, 0); PG8_STAGE(PG8_SA(0, 1), a2 + hstep, voffA);
            PG8_WAIT_V(8); PG8_WAIT_L(0); PG8_BAR; PG8_MMA(0, 0, At, B0); PG8_MMA(0, 1, At, B1); PG8_BAR; PG8_SCHED;
            PG8_LDA(At, 1, 1); PG8_STAGE(PG8_SB(1, 0), b3, voffB); PG8_STAGE(PG8_SB(1, 1), b3 + hstep, voffB); PG8_STAGE(PG8_SA(1, 0), a3, voffA);
            PG8_WAIT_V(8); PG8_WAIT_L(0); PG8_BAR; PG8_MMA(1, 0, At, B0); PG8_MMA(1, 1, At, B1); PG8_BAR; PG8_SCHED;
            } else {
            PG8_LDB(B0, 0, 0); PG8_SCHED; PG8_LDA(At, 0, 0); PG8_STAGE(PG8_SA(1, 1), a1 + hstep, voffA);
            PG8_WAIT_L(8); PG8_BAR; PG8_WAIT_L(0); PG8_MMA(0, 0, At, B0); PG8_BAR; PG8_SCHED;
            PG8_LDB(B1, 0, 1); PG8_STAGE(PG8_SB(0, 0), b2, voffB);
            PG8_BAR; PG8_WAIT_L(0); PG8_MMA(0, 1, At, B1); PG8_BAR;
            PG8_LDA(At, 0, 1); PG8_STAGE(PG8_SA(0, 0), a2, voffA);
            PG8_BAR; PG8_WAIT_L(0); PG8_MMA(1, 0, At, B0); PG8_BAR; PG8_SCHED;
            PG8_STAGE(PG8_SB(0, 1), b2 + hstep, voffB);
            PG8_WAIT_V(6); PG8_BAR; PG8_MMA(1, 1, At, B1); PG8_BAR;
            PG8_LDB(B0, 1, 0); PG8_SCHED; PG8_LDA(At, 1, 0); PG8_STAGE(PG8_SA(0, 1), a2 + hstep, voffA);
            PG8_WAIT_L(8); PG8_BAR; PG8_WAIT_L(0); PG8_MMA(0, 0, At, B0); PG8_BAR; PG8_SCHED;
            PG8_LDB(B1, 1, 1); PG8_STAGE(PG8_SB(1, 0), b3, voffB);
            PG8_BAR; PG8_WAIT_L(0); PG8_MMA(0, 1, At, B1); PG8_BAR;
            PG8_LDA(At, 1, 1); PG8_STAGE(PG8_SA(1, 0), a3, voffA);
            PG8_BAR; PG8_WAIT_L(0); PG8_MMA(1, 0, At, B0); PG8_BAR; PG8_SCHED;
            PG8_STAGE(PG8_SB(1, 1), b3 + hstep, voffB);
            PG8_WAIT_V(6); PG8_BAR; PG8_MMA(1, 1, At, B1); PG8_BAR;
            }
        }
        if constexpr (ALIGN_EPI) { if (wr == 0) PG8_BAR; }
        if constexpr (!Epi::AFTER_DRAIN) { E(acc, cur, wr, wc, fr, fq); S.done(cur); }
        if (!has_next) break;
#pragma unroll
        for (int a = 0; a < 2; ++a)
#pragma unroll
            for (int b = 0; b < 2; ++b)
#pragma unroll
                for (int m = 0; m < 4; ++m)
#pragma unroll
                    for (int n = 0; n < 2; ++n) acc[a][b][m][n] = (f32x4){0.f, 0.f, 0.f, 0.f};
        cur = nxt; cA = nA; cB = nB; ++ui;
        if constexpr (ALIGN_EPI) { if (wr == 1) PG8_BAR; }
    }
    PG8_WAIT_V(0);
    if constexpr (!ALIGN_EPI) { if (wr == 0) PG8_BAR; }
    PG8_BAR;
    if constexpr (Epi::AFTER_DRAIN) { E.fused(acc, cur, wr, wc, fr, fq, lds, wid, lane); S.done(cur); }
#undef PG8_SA
#undef PG8_SB
#undef PG8_STAGE
#undef PG8_LDA
#undef PG8_LDB
#undef PG8_MMA
#undef PG8_WAIT_V
#undef PG8_WAIT_L
#undef PG8_BAR
#undef PG8_SCHED
}
}
typedef unsigned short bf16;
typedef float f32x4 __attribute__((ext_vector_type(4)));
typedef float f32x16 __attribute__((ext_vector_type(16)));
typedef short bf16x8 __attribute__((ext_vector_type(8)));
typedef unsigned u32x4 __attribute__((ext_vector_type(4)));
typedef unsigned u32x2 __attribute__((ext_vector_type(2)));
#define LAS __attribute__((address_space(3)))
#define DI __device__ __forceinline__

constexpr int D = 1024, NTOK = 65536, HTOK = 32768, DFF = 2816, NW = 8;
constexpr float EPS = 1e-6f, LOG2E = 1.4426950408889634f;
constexpr size_t MiB = (size_t)1 << 20;
constexpr size_t WS_LB = 0;
constexpr size_t WS_ROPE = 64 * 1024;
constexpr size_t WS_W1 = 2 * MiB;
constexpr size_t WS_W2 = 90 * MiB;
constexpr size_t WS_HGIN = 134 * MiB;
constexpr size_t WS_HGO = 154 * MiB;
constexpr size_t WS_SWQKV = 158 * MiB;
constexpr size_t WS_SWO = 161 * MiB;
constexpr size_t WS_NAQKV = 163 * MiB;
constexpr size_t WS_NAO = 169 * MiB;
constexpr size_t WS_SSQ = 172 * MiB;
constexpr size_t WS_XN = 176 * MiB;
constexpr size_t WS_AR = 304 * MiB;
constexpr size_t AR_VT = 256 * MiB, AR_OB = 320 * MiB;
constexpr size_t WS_NEED = 704 * MiB;
constexpr int LDS_BYTES = 147456;

typedef float f32x2_t __attribute__((ext_vector_type(2))); typedef __bf16 bf16x2_t __attribute__((ext_vector_type(2)));
DI unsigned cvtpk(float lo, float hi) { const f32x2_t v = {lo, hi}; const bf16x2_t b = __builtin_convertvector(v, bf16x2_t); return __builtin_bit_cast(unsigned, b); }
DI float bf2f(unsigned short b) { return __uint_as_float((unsigned)b << 16); }
DI float bflo(unsigned w) { return __uint_as_float(w << 16); }
DI float bfhi(unsigned w) { return __uint_as_float(w & 0xffff0000u); }
DI unsigned short f2bf(float f) { return (unsigned short)(cvtpk(f, 0.f) & 0xffffu); }
DI float h2f(unsigned short h) { return (float)__builtin_bit_cast(_Float16, h); }
DI float wave_sum(float v) {
#pragma unroll
    for (int o = 1; o < 64; o <<= 1) v += __shfl_xor(v, o);
    return v;
}
DI int imin(int a, int b) { return a < b ? a : b; }
DI int imax(int a, int b) { return a > b ? a : b; }
DI int iclamp(int v, int lo, int hi) { return imin(imax(v, lo), hi); }

DI void transpose_item(const float* W, int K, int N, bf16* WT, int item, float* scr, int lane, bool swiglu, const float* gk) {
    const int nblk = N / 32, kb = item / nblk, nb = item % nblk, k0 = 64 * kb, n0 = 32 * nb;
#pragma unroll 8
    for (int i = 0; i < 32; ++i) { const int kk = 2 * i + (lane >> 5); scr[kk * 33 + (lane & 31)] = W[(size_t)(k0 + kk) * N + n0 + (lane & 31)] * (gk ? gk[k0 + kk] : 1.0f); }
    asm volatile("s_waitcnt lgkmcnt(0)" ::: "memory");
    int r0 = n0;
    if (swiglu) { r0 = (n0 < DFF) ? (n0 / 128) * 256 + (n0 % 128) : ((n0 - DFF) / 128) * 256 + 128 + ((n0 - DFF) % 128); }
    const int c = lane & 7;
#pragma unroll
    for (int j = 0; j < 4; ++j) { const int n = (lane >> 3) + 8 * j; const float* s = scr + (8 * c) * 33 + n;
        u32x4 o; o.x = cvtpk(s[0 * 33], s[1 * 33]); o.y = cvtpk(s[2 * 33], s[3 * 33]); o.z = cvtpk(s[4 * 33], s[5 * 33]); o.w = cvtpk(s[6 * 33], s[7 * 33]);
        *(u32x4*)(WT + (size_t)(r0 + n) * K + k0 + 8 * c) = o; }
    asm volatile("s_waitcnt lgkmcnt(0)" ::: "memory");
}
struct In { const float *xp, *xs, *norm_g, *fin_g, *w1, *w2, *hg_in, *hg_o, *hg_gn, *hg_lb, *sw_qkv, *sw_o, *sw_sink, *na_qkv, *na_o, *na_rpb; };
struct Args { In in; float* out; unsigned char* ws; double inv[8]; int lo, hi; };

DI void conv_phase(const In& I, unsigned char* ws, const double* inv, unsigned char* lds, int tid) {
    const int lane = tid & 63, wave = tid >> 6;
    float* scr = (float*)(lds + wave * 16384);
    const int gw = blockIdx.x * NW + wave, ngw = gridDim.x * NW;
    constexpr int I_W1 = 16 * 176, I_W2 = 44 * 32, I_HGIN = 16 * 160, I_SQ = 16 * 32, I_SWQ = 16 * 48, I_NAQ = 16 * 96;
    constexpr int NIT = 8 * I_W1 + 8 * I_W2 + 2 * I_HGIN + 2 * I_SQ + I_SWQ + I_SQ + I_NAQ + I_SQ;
    for (int it = gw; it < NIT; it += ngw) {
        int r = it;
        if (r < 8 * I_W1) { const int m = r / I_W1; transpose_item(I.w1 + (size_t)m * D * 2 * DFF, D, 2 * DFF, (bf16*)(ws + WS_W1) + (size_t)m * 2 * DFF * D, r % I_W1, scr, lane, true, I.norm_g + ((m >> 1) * 3 + (m & 1) * 2) * D); continue; } r -= 8 * I_W1;
        if (r < 8 * I_W2) { const int m = r / I_W2; transpose_item(I.w2 + (size_t)m * DFF * D, DFF, D, (bf16*)(ws + WS_W2) + (size_t)m * D * DFF, r % I_W2, scr, lane, false, nullptr); continue; } r -= 8 * I_W2;
        if (r < 2 * I_HGIN) { const int m = r / I_HGIN; transpose_item(I.hg_in + (size_t)m * D * 5 * D, D, 5 * D, (bf16*)(ws + WS_HGIN) + (size_t)m * 5 * D * D, r % I_HGIN, scr, lane, false, I.norm_g + (m * 9 + 1) * D); continue; } r -= 2 * I_HGIN;
        if (r < 2 * I_SQ) { const int m = r / I_SQ; transpose_item(I.hg_o + (size_t)m * D * D, D, D, (bf16*)(ws + WS_HGO) + (size_t)m * D * D, r % I_SQ, scr, lane, false, nullptr); continue; } r -= 2 * I_SQ;
        if (r < I_SWQ) { transpose_item(I.sw_qkv, D, 1536, (bf16*)(ws + WS_SWQKV), r, scr, lane, false, I.norm_g + 4 * D); continue; } r -= I_SWQ;
        if (r < I_SQ) { transpose_item(I.sw_o, D, D, (bf16*)(ws + WS_SWO), r, scr, lane, false, nullptr); continue; } r -= I_SQ;
        if (r < I_NAQ) { transpose_item(I.na_qkv, D, 3072, (bf16*)(ws + WS_NAQKV), r, scr, lane, false, I.norm_g + 7 * D); continue; } r -= I_NAQ;
        transpose_item(I.na_o, D, D, (bf16*)(ws + WS_NAO), r, scr, lane, false, nullptr);
    }
    const int gt = blockIdx.x * 512 + tid, ngt = gridDim.x * 512;
    float* lbt = (float*)(ws + WS_LB);
    for (int i = gt; i < 2048; i += ngt) { const int d = i >> 10, c = i & 1023;
        float v[4], mx = -1e30f;
        for (int l = 0; l < 4; ++l) { v[l] = I.hg_lb[(d * 4 + l) * 1024 + c]; mx = fmaxf(mx, v[l]); }
        float s = 0.f; for (int l = 0; l < 4; ++l) { v[l] = __expf(v[l] - mx); s += v[l]; }
        float cum = 0.f; lbt[(0 * 2 + d) * 1024 + c] = 0.f;
        for (int l = 1; l < 4; ++l) { cum += v[l] / s; lbt[(l * 2 + d) * 1024 + c] = cum; } }
    float* rt = (float*)(ws + WS_ROPE);
    for (int i = gt; i < 4096 * 8; i += ngt) { const int pos = i >> 3, j = i & 7;
        const double ang = (double)pos * inv[j]; const double TWO_PI = 6.283185307179586476925;
        const double r = ang - TWO_PI * __builtin_rint(ang / TWO_PI), r2 = r * r;
        double ts = r, sn = r, tc = 1.0, cs = 1.0;
        for (int n = 1; n <= 13; ++n) { ts *= -r2 / (double)((2 * n) * (2 * n + 1)); sn += ts; tc *= -r2 / (double)((2 * n - 1) * (2 * n)); cs += tc; }
        rt[pos * 16 + j] = (float)cs; rt[pos * 16 + 8 + j] = (float)sn; }
}

DI void norm_phase(const float* xp, const float* xs, float* xio, const float* g, bf16* XN, float* ssq, float* fout, int tid) {
    const int lane = tid & 63, wave = tid >> 6;
    const int gw = blockIdx.x * NW + wave, ngw = gridDim.x * NW;
    f32x4 gv[4];
#pragma unroll
    for (int j = 0; j < 4; ++j) gv[j] = g ? ((const f32x4*)g)[64 * j + lane] : (f32x4){1.f, 1.f, 1.f, 1.f};
    for (int row = gw; row < NTOK; row += ngw) {
        const float* src = xp ? (row < HTOK ? xp + (size_t)row * D : xs + (size_t)(row - HTOK) * D) : xio + (size_t)row * D;
        const f32x4* xr = (const f32x4*)src + lane;
        f32x4 v[4]; float ss = 0.f;
#pragma unroll
        for (int j = 0; j < 4; ++j) { v[j] = xr[64 * j]; ss += (v[j].x * v[j].x + v[j].y * v[j].y) + (v[j].z * v[j].z + v[j].w * v[j].w); }
        ss = wave_sum(ss);
        const float rstd = 1.0f / sqrtf(ss * (1.0f / D) + EPS);
        if (xp) { f32x4* xo = (f32x4*)(xio + (size_t)row * D) + lane;
#pragma unroll
            for (int j = 0; j < 4; ++j) xo[64 * j] = v[j]; }
        if (XN) { u32x2* o = (u32x2*)(XN + (size_t)row * D) + lane;
#pragma unroll
            for (int j = 0; j < 4; ++j) { const f32x4 y = v[j]; u32x2 w; w.x = cvtpk(y.x, y.y); w.y = cvtpk(y.z, y.w); o[64 * j] = w; }
            if (lane < 16) ssq[(size_t)row * 16 + lane] = (lane == 0) ? ss : 0.f; }
        if (fout) { f32x4* o = (f32x4*)(fout + (size_t)row * D) + lane;
#pragma unroll
            for (int j = 0; j < 4; ++j) o[64 * j] = v[j] * rstd * gv[j]; }
    }
}

DI void seq_of(int row, int& base, int& len) { if (row < HTOK) { len = 4096; base = row & ~4095; } else { len = 2048; base = HTOK + ((row - HTOK) & ~2047); } }

DI void rope_phase(bf16* QK, const float* rt, int tid) {
    const int gt = blockIdx.x * 512 + tid, ngt = gridDim.x * 512;
    for (int i = gt; i < NTOK * 20; i += ngt) { const int row = i / 20, hd = i % 20;
        int base, len; seq_of(row, base, len); const int pos = row - base;
        u32x4* p = (u32x4*)(QK + (size_t)row * 1280 + hd * 64);
        const u32x4 a = p[0], b = p[1];
        const f32x4* t = (const f32x4*)(rt + pos * 16); const f32x4 c0 = t[0], c1 = t[1], s0 = t[2], s1 = t[3];
        const float cs[8] = {c0.x, c0.y, c0.z, c0.w, c1.x, c1.y, c1.z, c1.w}, sn[8] = {s0.x, s0.y, s0.z, s0.w, s1.x, s1.y, s1.z, s1.w};
        const unsigned aw[4] = {a.x, a.y, a.z, a.w}, bw[4] = {b.x, b.y, b.z, b.w};
        unsigned oa[4], ob[4];
#pragma unroll
        for (int w = 0; w < 4; ++w) {
            const float x1l = bflo(aw[w]), x1h = bfhi(aw[w]), x2l = bflo(bw[w]), x2h = bfhi(bw[w]);
            oa[w] = cvtpk(x1l * cs[2 * w] - x2l * sn[2 * w], x1h * cs[2 * w + 1] - x2h * sn[2 * w + 1]);
            ob[w] = cvtpk(x2l * cs[2 * w] + x1l * sn[2 * w], x2h * cs[2 * w + 1] + x1h * sn[2 * w + 1]); }
        p[0] = (u32x4){oa[0], oa[1], oa[2], oa[3]}; p[1] = (u32x4){ob[0], ob[1], ob[2], ob[3]};
    }
}

DI int crow(int r, int hi) { return (r & 3) + 8 * (r >> 2) + 4 * hi; }
#define MFMA32(a, b, c) __builtin_amdgcn_mfma_f32_32x32x16_bf16((a), (b), (c), 0, 0, 0)
struct KVFrag { bf16x8 k[4]; u32x2 v[2][2][2]; };
DI void kv_load(KVFrag& f, const bf16* Kp  , int ldq, const bf16* Vp  , int tok0, int l32) {
    const bf16* kr = Kp + (size_t)(tok0 + l32) * ldq;
#pragma unroll
    for (int s = 0; s < 4; ++s) f.k[s] = *(const bf16x8*)(kr + 16 * s);
#pragma unroll
    for (int dt = 0; dt < 2; ++dt)
#pragma unroll
        for (int ks = 0; ks < 2; ++ks) { const bf16* vp = Vp + (size_t)dt * 32 * NTOK + tok0 + 16 * ks;
            f.v[dt][ks][0] = *(const u32x2*)vp; f.v[dt][ks][1] = *(const u32x2*)(vp + 8); }
}
template <class F> DI void attn_wave(const F& f, const bf16* QK, int ldq, int qcol, int kcol, const bf16* VT, int vrow, bf16* AO, int ocol, int qtok, float m0, float l0, int lane) {
    const int l32 = lane & 31, hi = lane >> 5;
    bf16x8 qf[4];
    { const bf16* qp = QK + (size_t)qtok * ldq + qcol + 8 * hi;
#pragma unroll
      for (int s = 0; s < 4; ++s) qf[s] = *(const bf16x8*)(qp + 16 * s); }
    const bf16* Kp = QK + kcol + 8 * hi; const bf16* Vp = VT + (size_t)(vrow + l32) * NTOK + 4 * hi;
    float m = m0, l = l0; f32x16 o0 = {}, o1 = {};
    const int nt = f.ntiles();
    KVFrag cur, nxt;
    kv_load(cur, Kp, ldq, Vp, f.tok0(0), l32);
    for (int i = 0; i < nt; ++i) {
        if (i + 1 < nt) kv_load(nxt, Kp, ldq, Vp, f.tok0(i + 1), l32);
        f32x16 s = {};
#pragma unroll
        for (int st = 0; st < 4; ++st) s = MFMA32(cur.k[st], qf[st], s);
        float tmax = -INFINITY;
#pragma unroll
        for (int r = 0; r < 16; ++r) { s[r] = f.score(i, r, s[r]); tmax = fmaxf(tmax, s[r]); }
        tmax = fmaxf(tmax, __shfl_xor(tmax, 32));
        const float mn = fmaxf(m, tmax), fs = __builtin_amdgcn_exp2f(m - mn);
        float ps = 0.f;
#pragma unroll
        for (int r = 0; r < 16; ++r) { s[r] = __builtin_amdgcn_exp2f(s[r] - mn); ps += s[r]; }
        l = l * fs + ps; m = mn;
#pragma unroll
        for (int r = 0; r < 16; ++r) { o0[r] *= fs; o1[r] *= fs; }
#pragma unroll
        for (int ks = 0; ks < 2; ++ks) {
            u32x4 pw; pw.x = cvtpk(s[8 * ks], s[8 * ks + 1]); pw.y = cvtpk(s[8 * ks + 2], s[8 * ks + 3]); pw.z = cvtpk(s[8 * ks + 4], s[8 * ks + 5]); pw.w = cvtpk(s[8 * ks + 6], s[8 * ks + 7]);
            const bf16x8 pb = __builtin_bit_cast(bf16x8, pw);
            const u32x4 va = {cur.v[0][ks][0].x, cur.v[0][ks][0].y, cur.v[0][ks][1].x, cur.v[0][ks][1].y};
            const u32x4 vb = {cur.v[1][ks][0].x, cur.v[1][ks][0].y, cur.v[1][ks][1].x, cur.v[1][ks][1].y};
            o0 = MFMA32(__builtin_bit_cast(bf16x8, va), pb, o0);
            o1 = MFMA32(__builtin_bit_cast(bf16x8, vb), pb, o1);
        }
        if (i + 1 < nt) cur = nxt;
    }
    l += __shfl_xor(l, 32);
    const float rl = 1.0f / l;
    bf16* op = AO + (size_t)qtok * D + ocol + 4 * hi;
#pragma unroll
    for (int g = 0; g < 4; ++g) {
        u32x2 w0, w1; w0.x = cvtpk(o0[4 * g] * rl, o0[4 * g + 1] * rl); w0.y = cvtpk(o0[4 * g + 2] * rl, o0[4 * g + 3] * rl);
        w1.x = cvtpk(o1[4 * g] * rl, o1[4 * g + 1] * rl); w1.y = cvtpk(o1[4 * g + 2] * rl, o1[4 * g + 3] * rl);
        *(u32x2*)(op + 8 * g) = w0; *(u32x2*)(op + 32 + 8 * g) = w1; }
}
struct SwaF {
    int sb, len, q0, qpos, hi;
    DI int ntiles() const { return imin(q0 + 160, len) / 32 - imax(q0 - 128, 0) / 32; }
    DI int kst(int i) const { return imax(q0 - 128, 0) + 32 * i; }
    DI int tok0(int i) const { return sb + kst(i); }
    DI float score(int i, int r, float raw) const { const int kpos = kst(i) + crow(r, hi); const int d = kpos - qpos; return (d <= 128 && d >= -128) ? raw * (0.125f * LOG2E) : -INFINITY; }
};
DI void swa_phase(const bf16* QK, const bf16* VT, bf16* AO, const float* sinks, int tid) {
    const int lane = tid & 63, wave = tid >> 6, gw = blockIdx.x * NW + wave, ngw = gridDim.x * NW;
    for (int u = gw; u < (NTOK / 32) * 16; u += ngw) {
        const int tb = u >> 4, hq = u & 15, row = tb * 32;
        SwaF f; seq_of(row, f.sb, f.len); f.q0 = row - f.sb; f.qpos = f.q0 + (lane & 31); f.hi = lane >> 5;
        attn_wave(f, QK, 1280, hq * 64, 1024 + (hq >> 2) * 64, VT, (hq >> 2) * 64, AO, hq * 64, row + (lane & 31), sinks[hq] * LOG2E, (lane >> 5) ? 0.f : 1.f, lane);
    }
}
struct NaF {
    int sb, rsA, nt, cst, qrow, qcol, rsq, csq, hi; const float* rpb;
    DI int ntiles() const { return nt; }
    DI int tok0(int i) const { return sb + (rsA + i) * 64 + cst; }
    DI float score(int i, int r, float raw) const {
        const int R = rsA + i, kc = cst + crow(r, hi);
        const bool ok = (R >= rsq) && (R < rsq + 8) && (kc >= csq) && (kc < csq + 16);
        const int dr = iclamp(R - qrow + 7, 0, 14), dc = iclamp(kc - qcol + 15, 0, 30);
        return ok ? (raw * 0.125f + rpb[dr * 32 + dc]) * LOG2E : -INFINITY; }
};
DI void na_phase(const bf16* QK, const bf16* VT, bf16* AO, const float* rpbg, unsigned char* lds, int tid) {
    const int lane = tid & 63, wave = tid >> 6, gw = blockIdx.x * NW + wave, ngw = gridDim.x * NW;
    float* rp = (float*)lds;
    for (int i = tid; i < 16 * 15 * 32; i += 512) { const int c = i & 31, hr = i >> 5; rp[i] = (c < 31) ? rpbg[hr * 31 + c] : 0.f; }
    __syncthreads();
    for (int u = gw; u < 2048 * 16; u += ngw) {
        const int g = u >> 4, h = u & 15;
        int rows, seqb, rem;
        if (g < 1024) { rows = 64; seqb = (g >> 7) * 4096; rem = g & 127; } else { const int g2 = g - 1024; rows = 32; seqb = HTOK + (g2 >> 6) * 2048; rem = g2 & 63; }
        const int rpair = rem >> 2, j = rem & 3, r0 = 2 * rpair, ql = lane & 31;
        NaF f; f.sb = seqb; f.rsA = iclamp(r0 - 4, 0, rows - 8); const int rsB = iclamp(r0 - 3, 0, rows - 8); f.nt = rsB + 8 - f.rsA;
        f.cst = iclamp(16 * j - 8, 0, 32); f.qrow = r0 + (ql >> 4); f.qcol = 16 * j + (ql & 15);
        f.rsq = iclamp(f.qrow - 4, 0, rows - 8); f.csq = iclamp(f.qcol - 8, 0, 48); f.hi = lane >> 5; f.rpb = rp + h * 15 * 32;
        attn_wave(f, QK, 2048, h * 64, 1024 + h * 64, VT, h * 64, AO, h * 64, seqb + f.qrow * 64 + f.qcol, -1e30f, 0.f, lane);
    }
    __syncthreads();
}

#define MFMA16(a, b, c) __builtin_amdgcn_mfma_f32_16x16x32_bf16((a), (b), (c), 0, 0, 0)
constexpr int SQ = 136, ST = 72;
constexpr int L_QR = 0, L_KR = 17408, L_VRAW = 34816, L_KRT = 44032, L_VT = 62464, L_AM = 71680, L_SPT = 80896, L_SEG = 98304, L_EMID = 100352, L_EEND = 100864;
DI float cexp(float x) { return __expf(fminf(fmaxf(x, -80.f), 80.f)); }
DI void scan_phase(const bf16* P, bf16* OF, bf16* OB, int half, unsigned char* lds, int tid) {
    const int lane = tid & 63, wave = tid >> 6, l16 = lane & 15, rq = lane >> 4;
    const int Tlen = half ? 2048 : 4096, nseq = half ? 16 : 8, NC = Tlen / 64, nitems = nseq * 32;
    bf16* QR = (bf16*)(lds + L_QR); bf16* KR = (bf16*)(lds + L_KR); bf16* VRAW = (bf16*)(lds + L_VRAW); bf16* KRT = (bf16*)(lds + L_KRT);
    bf16* VT = (bf16*)(lds + L_VT); bf16* AM = (bf16*)(lds + L_AM); bf16* SPT = (bf16*)(lds + L_SPT);
    float* SEG = (float*)(lds + L_SEG); float* EMID = (float*)(lds + L_EMID); float* EEND = (float*)(lds + L_EEND);
    const int lr = tid >> 3, lc = tid & 7;
    for (int item = blockIdx.x; item < nitems; item += gridDim.x) {
        const int vs = item & 1, dir = (item >> 1) & 1, h = (item >> 2) & 7, seq = item >> 5;
        const bf16* Pq = P + (size_t)seq * Tlen * 5120 + h * 128;
        const bf16* Pv = Pq + 1024 + vs * 64;
        const bf16* Pl = Pq + 3072 + dir * 1024;
        bf16* Oo = (dir ? OB : OF) + (size_t)seq * Tlen * D + h * 128 + vs * 64;
        f32x4 S[4];
#pragma unroll
        for (int i = 0; i < 4; ++i) S[i] = (f32x4){0.f, 0.f, 0.f, 0.f};
        u32x4 pq0, pq1, pl0, pl1, pv;
#define SC_TOK(c, tau) (dir ? (Tlen - 1 - ((c) * 64 + (tau))) : ((c) * 64 + (tau)))
#define SC_LOAD(c) do { const size_t ro = (size_t)SC_TOK(c, lr) * 5120; \
            pq0 = *(const u32x4*)(Pq + ro + lc * 8); pq1 = *(const u32x4*)(Pq + ro + 64 + lc * 8); \
            pl0 = *(const u32x4*)(Pl + ro + lc * 8); pl1 = *(const u32x4*)(Pl + ro + 64 + lc * 8); \
            pv = *(const u32x4*)(Pv + ro + lc * 8); } while (0)
        SC_LOAD(0);
        for (int c = 0; c < NC; ++c) {
            *(u32x4*)(QR + lr * SQ + lc * 8) = pq0; *(u32x4*)(QR + lr * SQ + 64 + lc * 8) = pq1;
            *(u32x4*)(KR + lr * SQ + lc * 8) = pl0; *(u32x4*)(KR + lr * SQ + 64 + lc * 8) = pl1;
            *(u32x4*)(VRAW + lr * ST + lc * 8) = pv;
            if (c + 1 < NC) SC_LOAD(c + 1);
            __syncthreads();
            const int k = tid & 127, seg = tid >> 7;
            float lf[16], cs[16]; float run = 0.f;
#pragma unroll
            for (int i = 0; i < 16; ++i) { lf[i] = h2f(KR[(16 * seg + i) * SQ + k]); run += lf[i]; cs[i] = run; }
            SEG[seg * 128 + k] = run;
            { const int v = tid & 63, ss = tid >> 6; unsigned short t[8];
#pragma unroll
              for (int i = 0; i < 8; ++i) t[i] = VRAW[(8 * ss + i) * ST + v];
              u32x4 w; w.x = t[0] | ((unsigned)t[1] << 16); w.y = t[2] | ((unsigned)t[3] << 16); w.z = t[4] | ((unsigned)t[5] << 16); w.w = t[6] | ((unsigned)t[7] << 16);
              *(u32x4*)(VT + v * ST + 8 * ss) = w; }
            __syncthreads();
            { const float t0 = SEG[k], t1 = SEG[128 + k], t2 = SEG[256 + k], t3 = SEG[384 + k];
              const float pre = (seg == 0) ? 0.f : (seg == 1) ? t0 : (seg == 2) ? (t0 + t1) : (t0 + t1 + t2);
              const float bmid = t0 + t1, bend = bmid + t2 + t3;
              unsigned short kb[16];
#pragma unroll
              for (int i = 0; i < 16; ++i) { const int tau = 16 * seg + i; const float dlt = pre + cs[i] - bmid;
                  const float qv = bf2f(QR[tau * SQ + k]); QR[tau * SQ + k] = f2bf(qv * cexp(dlt));
                  const float kv = 1.0f - __expf(lf[i]); kb[i] = f2bf(kv * cexp(-dlt)); KR[tau * SQ + k] = kb[i]; }
              u32x4 w0, w1; w0.x = kb[0] | ((unsigned)kb[1] << 16); w0.y = kb[2] | ((unsigned)kb[3] << 16); w0.z = kb[4] | ((unsigned)kb[5] << 16); w0.w = kb[6] | ((unsigned)kb[7] << 16);
              w1.x = kb[8] | ((unsigned)kb[9] << 16); w1.y = kb[10] | ((unsigned)kb[11] << 16); w1.z = kb[12] | ((unsigned)kb[13] << 16); w1.w = kb[14] | ((unsigned)kb[15] << 16);
              *(u32x4*)(KRT + k * ST + 16 * seg) = w0; *(u32x4*)(KRT + k * ST + 16 * seg + 8) = w1;
              if (seg == 0) { EMID[k] = cexp(bmid); EEND[k] = cexp(bend - bmid); } }
            __syncthreads();
            { const f32x4 em = *(const f32x4*)(EMID + 16 * wave + 4 * rq);
#pragma unroll
              for (int vb = 0; vb < 4; ++vb) { S[vb] = S[vb] * em; u32x2 w; w.x = cvtpk(S[vb][0], S[vb][1]); w.y = cvtpk(S[vb][2], S[vb][3]);
                  *(u32x2*)(SPT + (16 * vb + l16) * SQ + 16 * wave + 4 * rq) = w; } }
            { const int tb = wave >> 1;
#pragma unroll
              for (int sbi = 0; sbi < 2; ++sbi) { const int sb = 2 * (wave & 1) + sbi; f32x4 acc = {0.f, 0.f, 0.f, 0.f};
                  if (sb <= tb) {
#pragma unroll
                      for (int st = 0; st < 4; ++st) { const bf16x8 a = *(const bf16x8*)(KR + (16 * sb + l16) * SQ + 8 * rq + 32 * st), b = *(const bf16x8*)(QR + (16 * tb + l16) * SQ + 8 * rq + 32 * st); acc = MFMA16(a, b, acc); }
                      const int t = 16 * tb + l16, s0 = 16 * sb + 4 * rq;
#pragma unroll
                      for (int r = 0; r < 4; ++r) acc[r] = (s0 + r <= t) ? acc[r] : 0.f;
                  }
                  u32x2 w; w.x = cvtpk(acc[0], acc[1]); w.y = cvtpk(acc[2], acc[3]);
                  *(u32x2*)(AM + (16 * tb + l16) * ST + 16 * sb + 4 * rq) = w; } }
            __syncthreads();
            { const int tb = wave >> 1; const size_t orow = (size_t)SC_TOK(c, 16 * tb + l16) * D;
#pragma unroll
              for (int vbi = 0; vbi < 2; ++vbi) { const int vb = 2 * (wave & 1) + vbi; f32x4 acc = {0.f, 0.f, 0.f, 0.f};
#pragma unroll
                  for (int st = 0; st < 4; ++st) { const bf16x8 a = *(const bf16x8*)(SPT + (16 * vb + l16) * SQ + 8 * rq + 32 * st), b = *(const bf16x8*)(QR + (16 * tb + l16) * SQ + 8 * rq + 32 * st); acc = MFMA16(a, b, acc); }
#pragma unroll
                  for (int st = 0; st < 2; ++st) { const bf16x8 a = *(const bf16x8*)(VT + (16 * vb + l16) * ST + 8 * rq + 32 * st), b = *(const bf16x8*)(AM + (16 * tb + l16) * ST + 8 * rq + 32 * st); acc = MFMA16(a, b, acc); }
                  u32x2 w; w.x = cvtpk(acc[0], acc[1]); w.y = cvtpk(acc[2], acc[3]);
                  *(u32x2*)(Oo + orow + 16 * vb + 4 * rq) = w; } }
            { const bf16x8 a0 = *(const bf16x8*)(KRT + (16 * wave + l16) * ST + 8 * rq), a1 = *(const bf16x8*)(KRT + (16 * wave + l16) * ST + 8 * rq + 32);
              const f32x4 ee = *(const f32x4*)(EEND + 16 * wave + 4 * rq);
#pragma unroll
              for (int vb = 0; vb < 4; ++vb) { const bf16x8 b0 = *(const bf16x8*)(VT + (16 * vb + l16) * ST + 8 * rq), b1 = *(const bf16x8*)(VT + (16 * vb + l16) * ST + 8 * rq + 32);
                  S[vb] = MFMA16(a0, b0, S[vb]); S[vb] = MFMA16(a1, b1, S[vb]); S[vb] = S[vb] * ee; } }
            __syncthreads();
        }
#undef SC_LOAD
#undef SC_TOK
    }
}
DI void combine_phase(bf16* OF, const bf16* OB, const bf16* P, const float* gn, int tid) {
    const int lane = tid & 63, wave = tid >> 6, gw = blockIdx.x * NW + wave, ngw = gridDim.x * NW;
    float gv[16];
#pragma unroll
    for (int i = 0; i < 16; ++i) gv[i] = gn[16 * lane + i];
    for (int row = gw; row < HTOK; row += ngw) {
        const u32x4* pf = (const u32x4*)(OF + (size_t)row * D + 16 * lane); const u32x4* pb = (const u32x4*)(OB + (size_t)row * D + 16 * lane);
        const u32x4* pg = (const u32x4*)(P + (size_t)row * 5120 + 2048 + 16 * lane);
        const u32x4 f0 = pf[0], f1 = pf[1], b0 = pb[0], b1 = pb[1], g0 = pg[0], g1 = pg[1];
        const unsigned fw[8] = {f0.x, f0.y, f0.z, f0.w, f1.x, f1.y, f1.z, f1.w}, bw[8] = {b0.x, b0.y, b0.z, b0.w, b1.x, b1.y, b1.z, b1.w}, gw8[8] = {g0.x, g0.y, g0.z, g0.w, g1.x, g1.y, g1.z, g1.w};
        float o[16]; float ss = 0.f;
#pragma unroll
        for (int i = 0; i < 8; ++i) { o[2 * i] = bflo(fw[i]) + bflo(bw[i]); o[2 * i + 1] = bfhi(fw[i]) + bfhi(bw[i]); ss += o[2 * i] * o[2 * i] + o[2 * i + 1] * o[2 * i + 1]; }
        ss += __shfl_xor(ss, 1); ss += __shfl_xor(ss, 2); ss += __shfl_xor(ss, 4);
        const float rstd = 1.0f / sqrtf(ss * (1.0f / 128.0f) + EPS);
        unsigned ow[8];
#pragma unroll
        for (int i = 0; i < 8; ++i) { const float ga = bflo(gw8[i]), gb = bfhi(gw8[i]);
            const float ya = o[2 * i] * rstd * gv[2 * i] * (ga * pg8::fast_sigmoid(ga)), yb = o[2 * i + 1] * rstd * gv[2 * i + 1] * (gb * pg8::fast_sigmoid(gb));
            ow[i] = cvtpk(ya, yb); }
        u32x4* po = (u32x4*)(OF + (size_t)row * D + 16 * lane);
        po[0] = (u32x4){ow[0], ow[1], ow[2], ow[3]}; po[1] = (u32x4){ow[4], ow[5], ow[6], ow[7]};
    }
}

template <class Epi> DI void run_gemm(unsigned char* lds, const bf16* A, const bf16* Bt, int M, int N, int K, const Epi& E, int tid) {
    int bx = blockIdx.x; asm volatile("" : "+s"(bx));
    pg8::Gemm g{A, Bt, M, N, K}; pg8::StaticOrder S; S.init(M, N, (int)gridDim.x, bx);
    pg8::gemm_phase<Epi, pg8::StaticOrder, true, true>((LAS unsigned char*)lds, g, S, E, tid);
    __syncthreads();
}

__global__ void __launch_bounds__(512, 2) fwd(Args a) {
    extern __shared__ __attribute__((aligned(16))) unsigned char lds[];
    cg::grid_group grid = cg::this_grid();
    unsigned char* ws = a.ws;
    const In& I = a.in;
    float* X = a.out;
    bf16* XN = (bf16*)(ws + WS_XN);
    bf16* AR = (bf16*)(ws + WS_AR);
    const int lo = a.lo, hi = a.hi;
    int pc = 0;
#ifndef REP_NORM
#define REP_NORM 1
#endif
#ifndef REP_SCAN
#define REP_SCAN 1
#endif
#ifndef REP_ATTN
#define REP_ATTN 1
#endif
#ifndef REP_FFN1
#define REP_FFN1 1
#endif
#ifndef REP_SYNC
#define REP_SYNC 1
#endif
#define PH_BEGIN if (pc >= lo && pc < hi) { int tid = threadIdx.x; asm volatile("" : "+v"(tid));
#define PH_END if (pc + 1 < hi) { for (int rs_ = 0; rs_ < REP_SYNC; ++rs_) grid.sync(); } } ++pc;

    float* SSQ = (float*)(ws + WS_SSQ);
#define SSQ_OF(li_, sub_) (SSQ)
    PH_BEGIN conv_phase(I, ws, a.inv, lds, tid); norm_phase(I.xp, I.xs, X, nullptr, XN, SSQ_OF(0, 0), nullptr, tid); PH_END
    for (int li = 0; li < 4; ++li) {
        for (int sub = 0; sub < 3; ++sub) {
            if (sub != 1) {
                const int fi = li * 2 + (sub >> 1);
                if (sub == 2) { PH_BEGIN for (int rp_ = 0; rp_ < REP_NORM; ++rp_) norm_phase(nullptr, nullptr, X, nullptr, XN, SSQ_OF(li, 2), nullptr, tid); PH_END }
                PH_BEGIN for (int rp_ = 0; rp_ < REP_FFN1; ++rp_) { pg8::EpiSwiglu E{AR, DFF, SSQ_OF(li, sub)}; run_gemm(lds, XN, (const bf16*)(ws + WS_W1) + (size_t)fi * 2 * DFF * D, NTOK, 2 * DFF, D, E, tid); } PH_END
                PH_BEGIN { const bool fuse = !(li == 3 && sub == 2); float* nss = (sub == 0) ? SSQ_OF(li, 1) : SSQ_OF(li + 1, 0);
                           pg8::EpiResid E{X, D, 0.5f, fuse ? XN : nullptr, fuse ? nss : nullptr}; run_gemm(lds, AR, (const bf16*)(ws + WS_W2) + (size_t)fi * D * DFF, NTOK, D, DFF, E, tid); } PH_END
            } else {
                const int kind = li % 3;
                const float* ssq1 = SSQ_OF(li, 1);
                if (kind == 0) {
                    const int ia = li / 3;
                    for (int half = 0; half < 2; ++half) {
                        bf16* OF = XN + (size_t)half * HTOK * D; bf16* OB = (bf16*)(ws + WS_AR + AR_OB);
                        PH_BEGIN { pg8::EpiHg E{AR, (const float*)(ws + WS_LB) + li * 2048, ssq1 + (size_t)half * HTOK * 16}; run_gemm(lds, XN + (size_t)half * HTOK * D, (const bf16*)(ws + WS_HGIN) + (size_t)ia * 5 * D * D, HTOK, 5 * D, D, E, tid); } PH_END
                        PH_BEGIN for (int rp_ = 0; rp_ < REP_SCAN; ++rp_) scan_phase(AR, OF, OB, half, lds, tid); PH_END
                        PH_BEGIN combine_phase(OF, OB, AR, I.hg_gn + ia * D, tid); PH_END
                    }
                    PH_BEGIN { pg8::EpiResid E{X, D, 1.0f, nullptr, nullptr}; run_gemm(lds, XN, (const bf16*)(ws + WS_HGO) + (size_t)ia * D * D, NTOK, D, D, E, tid); } PH_END
                } else if (kind == 1) {
                    bf16* VT = (bf16*)(ws + WS_AR + AR_VT);
                    PH_BEGIN { pg8::EpiStore<false> E{AR, 1280, ssq1}; run_gemm(lds, XN, (const bf16*)(ws + WS_SWQKV), NTOK, 1280, D, E, tid); }
                             { pg8::EpiStore<true> E{VT, NTOK, ssq1}; run_gemm(lds, (const bf16*)(ws + WS_SWQKV) + (size_t)1280 * D, XN, 256, NTOK, D, E, tid); } PH_END
                    PH_BEGIN rope_phase(AR, (const float*)(ws + WS_ROPE), tid); PH_END
                    PH_BEGIN for (int rp_ = 0; rp_ < REP_ATTN; ++rp_) swa_phase(AR, VT, XN, I.sw_sink, tid); PH_END
                    PH_BEGIN { pg8::EpiResid E{X, D, 1.0f, nullptr, nullptr}; run_gemm(lds, XN, (const bf16*)(ws + WS_SWO), NTOK, D, D, E, tid); } PH_END
                } else {
                    bf16* VT = (bf16*)(ws + WS_AR + AR_VT);
                    PH_BEGIN { pg8::EpiStore<false> E{AR, 2048, ssq1}; run_gemm(lds, XN, (const bf16*)(ws + WS_NAQKV), NTOK, 2048, D, E, tid); }
                             { pg8::EpiStore<true> E{VT, NTOK, ssq1}; run_gemm(lds, (const bf16*)(ws + WS_NAQKV) + (size_t)2048 * D, XN, D, NTOK, D, E, tid); } PH_END
                    PH_BEGIN for (int rp_ = 0; rp_ < REP_ATTN; ++rp_) na_phase(AR, VT, XN, I.na_rpb, lds, tid); PH_END
                    PH_BEGIN { pg8::EpiResid E{X, D, 1.0f, nullptr, nullptr}; run_gemm(lds, XN, (const bf16*)(ws + WS_NAO), NTOK, D, D, E, tid); } PH_END
                }
            }
        }
    }
    PH_BEGIN norm_phase(nullptr, nullptr, X, I.fin_g, nullptr, nullptr, X, tid); PH_END
}
constexpr int NPHASES = 1 + 4 * 5 + (7 + 4 + 3 + 7) + 1;

#ifndef MULTI_LAUNCH
#define MULTI_LAUNCH 0
#endif
extern "C" void kernel_launch(void* const* d_in, const int* in_sizes, int n_in, void* d_out, int out_size, void* d_ws, size_t ws_size, hipStream_t stream) {
    static int grid = 0;
    if (grid == 0) {
        if (n_in != 16 || out_size != NTOK * D || ws_size < WS_NEED) { fprintf(stderr, "kernel_launch: unexpected shapes (n_in %d out %d ws %zu)\n", n_in, out_size, ws_size); grid = -1; return; }
        int dev = 0, cus = 0, per_cu = 0;
        hipGetDevice(&dev); hipDeviceGetAttribute(&cus, hipDeviceAttributeMultiprocessorCount, dev);
        if (hipFuncSetAttribute((const void*)fwd, hipFuncAttributeMaxDynamicSharedMemorySize, LDS_BYTES) != hipSuccess) { fprintf(stderr, "kernel_launch: hipFuncSetAttribute failed\n"); grid = -1; return; }
        if (hipOccupancyMaxActiveBlocksPerMultiprocessor(&per_cu, (const void*)fwd, 512, LDS_BYTES) != hipSuccess || per_cu < 1) { fprintf(stderr, "kernel_launch: occupancy query says %d\n", per_cu); per_cu = 1; }
        (void)hipGetLastError();
        grid = cus * per_cu;
    }
    if (grid < 0) return;
    Args a; memset(&a, 0, sizeof(a));
    const float** ip = (const float**)&a.in;
    for (int i = 0; i < 16; ++i) ip[i] = (const float*)d_in[i];
    a.out = (float*)d_out; a.ws = (unsigned char*)d_ws;
    for (int j = 0; j < 8; ++j) a.inv[j] = exp(-(double)j * (2.0 / 16.0) * log(500000.0));
#if MULTI_LAUNCH
    for (int p = 0; p < NPHASES; ++p) { a.lo = p; a.hi = p + 1; hipLaunchKernelGGL(fwd, dim3(grid), dim3(512), LDS_BYTES, stream, a); }
#else
    a.lo = 0; a.hi = NPHASES;
    void* args[] = {&a};
    hipError_t e = hipLaunchCooperativeKernel((const void*)fwd, dim3(grid), dim3(512), args, LDS_BYTES, stream);
    if (e != hipSuccess) fprintf(stderr, "cooperative launch failed: %s (grid %d)\n", hipGetErrorString(e), grid);
#endif
}
```

```cpp
#include <hip/hip_runtime.h>
#include <hip/hip_cooperative_groups.h>
#include <cstdio>
#include <cstdint>
#include <cstring>
#include <cmath>
namespace cg = cooperative_groups;
#ifndef GEMM_WGM
#define GEMM_WGM 8
#endif
namespace pg8 {
#define PG8_LAS __attribute__((address_space(3)))
typedef unsigned short bf16_t;
typedef short bf16x8 __attribute__((ext_vector_type(8)));
typedef float f32x4 __attribute__((ext_vector_type(4)));
typedef unsigned u32x4 __attribute__((ext_vector_type(4)));
constexpr int BM = 256, BK = 64, HALF = 128, HTB = HALF * BK * 2  , STAGE_BYTES = 8 * HTB, NXCD = 8, WGM = GEMM_WGM;

__host__ __device__ __forceinline__ int lds_byte(int r, int c) { const int st = (r >> 4) * 2 + (c >> 5), rr = r & 15, cc = c & 31, ob = rr * 64 + cc * 2; return st * 1024 + (ob ^ (((ob >> 9) & 1) << 5)); }
__host__ __device__ __forceinline__ void stage_rc(int b, int& R, int& C) { const int st = b / 1024, sb = b % 1024, swz = sb ^ (((sb >> 9) & 1) << 5); R = (st >> 1) * 16 + swz / 64; C = (st & 1) * 32 + (swz % 64) / 2; }
__host__ __device__ __forceinline__ int perm32(int rho) { const int n = rho >> 4, i = rho & 15; return 8 * (i >> 2) + 4 * n + (i & 3); }

struct Unit { int pm, pn, ord; };
struct Gemm { const bf16_t* A; const bf16_t* Bt; int M, N, K; };

struct StaticOrder {
    int nM, nN, nwg, G, c;
    __host__ __device__ void init(int M, int N, int G_, int c_) { nM = M / BM; nN = N / BM; nwg = nM * nN; G = G_; c = c_; }
    __host__ __device__ bool next(int i, Unit& u) const {
        const long L = (long)i * G + c; if (L >= nwg) return false; u.ord = i;
        int wgid = (int)L; { const int q = nwg / NXCD, r = nwg % NXCD, xcd = wgid % NXCD, off = wgid / NXCD; wgid = (xcd < r ? xcd * (q + 1) : r * (q + 1) + (xcd - r) * q) + off; }
        const int nig = WGM * nN, gid = wgid / nig, fm = gid * WGM, gsz = (nM - fm) < WGM ? (nM - fm) : WGM;
        u.pm = fm + ((wgid % nig) % gsz); u.pn = (wgid % nig) / gsz; return true;
    }
    __device__ __forceinline__ void a_ready(const Unit&) const {}
    __device__ __forceinline__ void done(const Unit&) const {}
};

typedef float f32x2c __attribute__((ext_vector_type(2))); typedef __bf16 bf16x2c __attribute__((ext_vector_type(2)));
__device__ __forceinline__ unsigned cvt_pk_bf16(float lo, float hi) { const f32x2c v = {lo, hi}; const bf16x2c b = __builtin_convertvector(v, bf16x2c); return __builtin_bit_cast(unsigned, b); }
typedef float f32x2 __attribute__((ext_vector_type(2)));
__device__ __forceinline__ float fast_sigmoid(float x) { return __builtin_amdgcn_rcpf(1.0f + __expf(-x)); }
__device__ __forceinline__ float rstd_row(const float* part, int row) { const f32x4* p = (const f32x4*)(part + (size_t)row * 16); const f32x4 a = p[0], b = p[1], c = p[2], d = p[3];
    const float ss = ((a[0] + a[1]) + (a[2] + a[3])) + ((b[0] + b[1]) + (b[2] + b[3])) + ((c[0] + c[1]) + (c[2] + c[3])) + ((d[0] + d[1]) + (d[2] + d[3]));
    return __builtin_amdgcn_rsqf(ss * (1.0f / 1024.0f) + 1e-6f); }
struct EpiSwiglu {
    static constexpr bool PERM = true, AFTER_DRAIN = false;
    bf16_t* H; int ldh; const float* rtab;
    __device__ __forceinline__ void operator()(const f32x4 (&acc)[2][2][4][2], const Unit& u, int wr, int wc, int fr, int fq) const {
        const int row0 = u.pm * BM + wr * 64 + fr, col0 = u.pn * HALF + wc * 32 + 8 * fq;
#pragma unroll
        for (int ai = 0; ai < 2; ++ai)
#pragma unroll
            for (int m = 0; m < 4; ++m) {
                const int row = row0 + ai * HALF + m * 16;
                bf16_t* rowp = H + (size_t)row * ldh + col0;
                const float rs = rtab[u.ord * 256 + wr * 64 + fr + ai * HALF + m * 16];
                const float nrl = rs * -1.4426950408889634f, rs2 = rs * rs;
                unsigned w[4];
#pragma unroll
                for (int n = 0; n < 2; ++n)
#pragma unroll
                    for (int p = 0; p < 2; ++p) {
                        const f32x2 g = {acc[ai][0][m][n][2 * p], acc[ai][0][m][n][2 * p + 1]}, up = {acc[ai][1][m][n][2 * p], acc[ai][1][m][n][2 * p + 1]};
                        const f32x2 a = g * nrl; f32x2 d; d.x = __builtin_amdgcn_exp2f(a.x); d.y = __builtin_amdgcn_exp2f(a.y);
                        d = d + 1.0f; f32x2 r; r.x = __builtin_amdgcn_rcpf(d.x); r.y = __builtin_amdgcn_rcpf(d.y);
                        const f32x2 h = ((g * up) * rs2) * r;
                        w[2 * n + p] = cvt_pk_bf16(h.x, h.y); }
                u32x4 wv = {w[0], w[1], w[2], w[3]};
                __builtin_nontemporal_store(wv, (u32x4*)rowp);
            }
    }
};
struct EpiResid {
    static constexpr bool PERM = true, AFTER_DRAIN = false;
    bf16_t* XB; float scale; float* ssq;
    __device__ __forceinline__ void operator()(const f32x4 (&acc)[2][2][4][2], const Unit& u, int wr, int wc, int fr, int fq) const {
        const int row0 = u.pm * BM + wr * 64 + fr, col0 = u.pn * BM + wc * 32 + 8 * fq;
        bf16_t* xb = XB + (size_t)row0 * 1024 + col0;
        u32x4 xo[8][2];
#pragma unroll
        for (int g = 0; g < 8; ++g) { const bf16_t* p_ = xb + (size_t)((g >> 2) * HALF + (g & 3) * 16) * 1024; xo[g][0] = *(const u32x4*)(p_); xo[g][1] = *(const u32x4*)(p_ + HALF); }
#pragma unroll
        for (int g = 0; g < 8; ++g) {
            const int ai = g >> 2, m = g & 3;
            const int row = row0 + ai * HALF + m * 16;
            bf16_t* rowp = XB + (size_t)row * 1024 + col0;
            float part = 0.f;
#pragma unroll
            for (int bj = 0; bj < 2; ++bj) {
                const unsigned w[4] = {xo[g][bj][0], xo[g][bj][1], xo[g][bj][2], xo[g][bj][3]};
                float t[8];
#pragma unroll
                for (int i = 0; i < 4; ++i) { t[2 * i] = __uint_as_float(w[i] << 16) + acc[ai][bj][m][i >> 1][(2 * i) & 3] * scale; t[2 * i + 1] = __uint_as_float(w[i] & 0xffff0000u) + acc[ai][bj][m][i >> 1][(2 * i + 1) & 3] * scale; }
#pragma unroll
                for (int i = 0; i < 8; ++i) part += t[i] * t[i];
                u32x4 o; o.x = cvt_pk_bf16(t[0], t[1]); o.y = cvt_pk_bf16(t[2], t[3]); o.z = cvt_pk_bf16(t[4], t[5]); o.w = cvt_pk_bf16(t[6], t[7]);
                *(u32x4*)(rowp + bj * HALF) = o;
            }
            part += __shfl_xor(part, 16); part += __shfl_xor(part, 32);
            if (fq == 0) ssq[(size_t)row * 16 + u.pn * 4 + wc] = part;
        }
    }
};
template <bool COLS> struct EpiStore {
    static constexpr bool PERM = true, AFTER_DRAIN = false;
    bf16_t* O; size_t ldo; const float* rtab;
    __device__ __forceinline__ void operator()(const f32x4 (&acc)[2][2][4][2], const Unit& u, int wr, int wc, int fr, int fq) const {
        const int row0 = u.pm * BM + wr * 64 + fr, col0 = u.pn * BM + wc * 32 + 8 * fq;
        f32x4 cs[2][2];
        if (COLS) {
#pragma unroll
            for (int bj = 0; bj < 2; ++bj)
#pragma unroll
                for (int n = 0; n < 2; ++n) cs[bj][n] = *(const f32x4*)(rtab + u.ord * 256 + wc * 32 + 8 * fq + bj * HALF + 4 * n);
        }
#pragma unroll
        for (int ai = 0; ai < 2; ++ai)
#pragma unroll
            for (int m = 0; m < 4; ++m) {
                const int row = row0 + ai * HALF + m * 16;
                bf16_t* rowp = O + (size_t)row * ldo + col0;
                const float rs = COLS ? 1.0f : rtab[u.ord * 256 + wr * 64 + fr + ai * HALF + m * 16];
#pragma unroll
                for (int bj = 0; bj < 2; ++bj) { const f32x4 v0 = COLS ? acc[ai][bj][m][0] * cs[bj][0] : acc[ai][bj][m][0] * rs, v1 = COLS ? acc[ai][bj][m][1] * cs[bj][1] : acc[ai][bj][m][1] * rs;
                    u32x4 w; w.x = cvt_pk_bf16(v0[0], v0[1]); w.y = cvt_pk_bf16(v0[2], v0[3]); w.z = cvt_pk_bf16(v1[0], v1[1]); w.w = cvt_pk_bf16(v1[2], v1[3]);
                    *(u32x4*)(rowp + bj * HALF) = w; }
            }
    }
};
__device__ __forceinline__ unsigned pk_f16(float a, float b) { const _Float16 ha = (_Float16)a, hb = (_Float16)b; return (unsigned)__builtin_bit_cast(unsigned short, ha) | ((unsigned)__builtin_bit_cast(unsigned short, hb) << 16); }
struct EpiHg {
    static constexpr bool PERM = true, AFTER_DRAIN = false;
    bf16_t* O; const float* lb; const float* rtab;
    __device__ __forceinline__ void operator()(const f32x4 (&acc)[2][2][4][2], const Unit& u, int wr, int wc, int fr, int fq) const {
        const int row0 = u.pm * BM + wr * 64 + fr, col0 = u.pn * BM + wc * 32 + 8 * fq;
        const bool gate = (u.pn >= 12);
        f32x4 lbv[2][2];
#pragma unroll
        for (int bj = 0; bj < 2; ++bj)
#pragma unroll
            for (int n = 0; n < 2; ++n) lbv[bj][n] = gate ? *(const f32x4*)(lb + (col0 - 3072) + bj * HALF + 4 * n) : (f32x4){0.f, 0.f, 0.f, 0.f};
#pragma unroll
        for (int ai = 0; ai < 2; ++ai)
#pragma unroll
            for (int m = 0; m < 4; ++m) {
                const int row = row0 + ai * HALF + m * 16;
                bf16_t* rowp = O + (size_t)row * 5120 + col0;
                const float rs = rtab[u.ord * 256 + wr * 64 + fr + ai * HALF + m * 16];
#pragma unroll
                for (int bj = 0; bj < 2; ++bj) { const f32x4 v0 = acc[ai][bj][m][0] * rs, v1 = acc[ai][bj][m][1] * rs;
                    u32x4 w;
                    if (gate) {
                        float o[8];
#pragma unroll
                        for (int e = 0; e < 4; ++e) { const float l0 = lbv[bj][0][e], l1 = lbv[bj][1][e];
                            o[e] = __log2f(l0 + (1.0f - l0) * fast_sigmoid(v0[e])); o[4 + e] = __log2f(l1 + (1.0f - l1) * fast_sigmoid(v1[e])); }
                        w.x = pk_f16(o[0], o[1]); w.y = pk_f16(o[2], o[3]); w.z = pk_f16(o[4], o[5]); w.w = pk_f16(o[6], o[7]);
                    } else { w.x = cvt_pk_bf16(v0[0], v0[1]); w.y = cvt_pk_bf16(v0[2], v0[3]); w.z = cvt_pk_bf16(v1[0], v1[1]); w.w = cvt_pk_bf16(v1[2], v1[3]); }
                    __builtin_nontemporal_store(w, (u32x4*)(rowp + bj * HALF)); }
            }
    }
};
template <class Epi, class Sched, bool ALIGN_EPI = false, bool SP2 = false>
__device__ __forceinline__ void gemm_phase(PG8_LAS unsigned char* lds, const Gemm g, const Sched& S, const Epi& E, const int tid) {
    const int wid = __builtin_amdgcn_readfirstlane(tid >> 6), lane = tid & 63, wr = wid >> 2, wc = wid & 3, fr = lane & 15, fq = lane >> 4;
    const int K = g.K, nt = K / BK;
    unsigned voffA[2], voffB[2];
#pragma unroll
    for (int i = 0; i < 2; ++i) { int R, C; stage_rc(tid * 16 + i * 8192, R, C); const int Rb = Epi::PERM ? ((R & ~31) + perm32(R & 31)) : R;
        voffA[i] = (unsigned)(R * K + C) * 2u; voffB[i] = (unsigned)(Rb * K + C) * 2u; }
    const size_t kstep = (size_t)(BK * 2);
    const size_t hstep = (size_t)HALF * K * 2;
    const size_t tstep = 2 * hstep;
    const unsigned ldsw = (unsigned)wid * 1024u;
    const int aoff = lds_byte(wr * 64 + fr, fq * 8), boff = lds_byte(wc * 32 + fr, fq * 8);
#define PG8_SA(b, h) (((b) * 2 + (h)) * HTB)
#define PG8_SB(b, h) ((4 + (b) * 2 + (h)) * HTB)
#define PG8_STAGE(bufoff, gbase, voff) do { _Pragma("unroll") for (int _i = 0; _i < 2; ++_i) \
        __builtin_amdgcn_global_load_lds((const unsigned*)((const char*)(gbase) + (voff)[_i]), (PG8_LAS unsigned*)(lds + (bufoff) + ldsw + _i * 8192), 16, 0, 0); } while (0)
#define PG8_LDA(dst, b, h) do { _Pragma("unroll") for (int m = 0; m < 4; ++m) _Pragma("unroll") for (int k = 0; k < 2; ++k) dst[m][k] = *(const PG8_LAS bf16x8*)(lds + PG8_SA(b, h) + aoff + m * 2048 + k * 1024); } while (0)
#define PG8_LDB(dst, b, h) do { _Pragma("unroll") for (int n = 0; n < 2; ++n) _Pragma("unroll") for (int k = 0; k < 2; ++k) dst[n][k] = *(const PG8_LAS bf16x8*)(lds + PG8_SB(b, h) + boff + n * 2048 + k * 1024); } while (0)
#define PG8_MMA(ai, bj, At, Bt) do { __builtin_amdgcn_s_setprio(1); _Pragma("unroll") for (int m = 0; m < 4; ++m) _Pragma("unroll") for (int n = 0; n < 2; ++n) _Pragma("unroll") for (int k = 0; k < 2; ++k) \
        acc[ai][bj][m][n] = __builtin_amdgcn_mfma_f32_16x16x32_bf16(Bt[n][k], At[m][k], acc[ai][bj][m][n], 0, 0, 0); __builtin_amdgcn_s_setprio(0); } while (0)
#define PG8_WAIT_V(n) asm volatile("s_waitcnt vmcnt(" #n ")" ::: "memory")
#define PG8_WAIT_L(n) asm volatile("s_waitcnt lgkmcnt(" #n ")" ::: "memory")
#define PG8_BAR __builtin_amdgcn_s_barrier()
#define PG8_SCHED __builtin_amdgcn_sched_barrier(0)
    Unit cur, nxt; int ui = 0;
    if (!S.next(0, cur)) return;
    f32x4 acc[2][2][4][2];
#pragma unroll
    for (int a = 0; a < 2; ++a)
#pragma unroll
        for (int b = 0; b < 2; ++b)
#pragma unroll
            for (int m = 0; m < 4; ++m)
#pragma unroll
                for (int n = 0; n < 2; ++n) acc[a][b][m][n] = (f32x4){0.f, 0.f, 0.f, 0.f};
    bf16x8 At[4][2], B0[2][2], B1[2][2];
    const char* cA = (const char*)g.A + (size_t)cur.pm * tstep; const char* cB = (const char*)g.Bt + (size_t)cur.pn * tstep;
    S.a_ready(cur);
    if constexpr (SP2) {
        PG8_STAGE(PG8_SB(0, 0), cB, voffB); PG8_STAGE(PG8_SB(0, 1), cB + hstep, voffB); PG8_STAGE(PG8_SA(0, 0), cA, voffA); PG8_STAGE(PG8_SA(0, 1), cA + hstep, voffA);
        if (wr == 1) PG8_BAR;
        PG8_WAIT_V(2); PG8_BAR;
        PG8_STAGE(PG8_SB(1, 0), cB + kstep, voffB); PG8_STAGE(PG8_SA(1, 0), cA + kstep, voffA); PG8_STAGE(PG8_SB(1, 1), cB + hstep + kstep, voffB);
        PG8_WAIT_V(6); PG8_BAR;
    } else {
        PG8_STAGE(PG8_SB(0, 0), cB, voffB); PG8_STAGE(PG8_SA(0, 0), cA, voffA); PG8_STAGE(PG8_SB(0, 1), cB + hstep, voffB); PG8_STAGE(PG8_SA(0, 1), cA + hstep, voffA);
        if (wr == 1) PG8_BAR;
        PG8_WAIT_V(4); PG8_BAR;
        PG8_STAGE(PG8_SB(1, 0), cB + kstep, voffB); PG8_STAGE(PG8_SA(1, 0), cA + kstep, voffA); PG8_STAGE(PG8_SB(1, 1), cB + hstep + kstep, voffB);
        PG8_WAIT_V(6); PG8_BAR;
    }
    for (;;) {
        const bool has_next = S.next(ui + 1, nxt);
        const char* nA = has_next ? (const char*)g.A + (size_t)nxt.pm * tstep : cA; const char* nB = has_next ? (const char*)g.Bt + (size_t)nxt.pn * tstep : cB;
        for (int t = 0; t < nt; t += 2) {
            const bool last = (t == nt - 2);
            const char* a1 = cA + (size_t)(t + 1) * kstep;
            const char* a2 = last ? nA : cA + (size_t)(t + 2) * kstep; const char* b2 = last ? nB : cB + (size_t)(t + 2) * kstep;
            const char* a3 = a2 + kstep; const char* b3 = b2 + kstep;
            if (last && has_next) S.a_ready(nxt);
            if constexpr (SP2) {
            PG8_LDB(B0, 0, 0); PG8_LDB(B1, 0, 1); PG8_SCHED; PG8_LDA(At, 0, 0); PG8_STAGE(PG8_SA(1, 1), a1 + hstep, voffA);
            PG8_WAIT_V(8); PG8_WAIT_L(0); PG8_BAR; PG8_MMA(0, 0, At, B0); PG8_MMA(0, 1, At, B1); PG8_BAR; PG8_SCHED;
            PG8_LDA(At, 0, 1); PG8_STAGE(PG8_SB(0, 0), b2, voffB); PG8_STAGE(PG8_SB(0, 1), b2 + hstep, voffB); PG8_STAGE(PG8_SA(0, 0), a2, voffA);
            PG8_WAIT_V(8); PG8_WAIT_L(0); PG8_BAR; PG8_MMA(1, 0, At, B0); PG8_MMA(1, 1, At, B1); PG8_BAR; PG8_SCHED;
            PG8_LDB(B0, 1, 0); PG8_LDB(B1, 1, 1); PG8_SCHED; PG8_LDA(At, 1, 0); PG8_STAGE(PG8_SA(0, 1), a2 + hstep, voffA);
            PG8_WAIT_V(8); PG8_WAIT_L(0); PG8_BAR; PG8_MMA(0, 0, At, B0); PG8_MMA(0, 1, At, B1); PG8_BAR; PG8_SCHED;
            PG8_LDA(At, 1, 1); PG8_STAGE(PG8_SB(1, 0), b3, voffB); PG8_STAGE(PG8_SB(1, 1), b3 + hstep, voffB); PG8_STAGE(PG8_SA(1, 0), a3, voffA);
            PG8_WAIT_V(8); PG8_WAIT_L(0); PG8_BAR; PG8_MMA(1, 0, At, B0); PG8_MMA(1, 1, At, B1); PG8_BAR; PG8_SCHED;
            } else {
            PG8_LDB(B0, 0, 0); PG8_SCHED; PG8_LDA(At, 0, 0); PG8_STAGE(PG8_SA(1, 1), a1 + hstep, voffA);
            PG8_WAIT_L(8); PG8_BAR; PG8_WAIT_L(0); PG8_MMA(0, 0, At, B0); PG8_BAR; PG8_SCHED;
            PG8_LDB(B1, 0, 1); PG8_STAGE(PG8_SB(0, 0), b2, voffB);
            PG8_BAR; PG8_WAIT_L(0); PG8_MMA(0, 1, At, B1); PG8_BAR;
            PG8_LDA(At, 0, 1); PG8_STAGE(PG8_SA(0, 0), a2, voffA);
            PG8_BAR; PG8_WAIT_L(0); PG8_MMA(1, 0, At, B0); PG8_BAR; PG8_SCHED;
            PG8_STAGE(PG8_SB(0, 1), b2 + hstep, voffB);
            PG8_WAIT_V(6); PG8_BAR; PG8_MMA(1, 1, At, B1); PG8_BAR;
            PG8_LDB(B0, 1, 0); PG8_SCHED; PG8_LDA(At, 1, 0); PG8_STAGE(PG8_SA(0, 1), a2 + hstep, voffA);
            PG8_WAIT_L(8); PG8_BAR; PG8_WAIT_L(0); PG8_MMA(0, 0, At, B0); PG8_BAR; PG8_SCHED;
            PG8_LDB(B1, 1, 1); PG8_STAGE(PG8_SB(1, 0), b3, voffB);
            PG8_BAR; PG8_WAIT_L(0); PG8_MMA(0, 1, At, B1); PG8_BAR;
            PG8_LDA(At, 1, 1); PG8_STAGE(PG8_SA(1, 0), a3, voffA);
            PG8_BAR; PG8_WAIT_L(0); PG8_MMA(1, 0, At, B0); PG8_BAR; PG8_SCHED;
            PG8_STAGE(PG8_SB(1, 1), b3 + hstep, voffB);
            PG8_WAIT_V(6); PG8_BAR; PG8_MMA(1, 1, At, B1); PG8_BAR;
            }
        }
        if constexpr (ALIGN_EPI) { if (wr == 0) PG8_BAR; }
        if constexpr (!Epi::AFTER_DRAIN) { E(acc, cur, wr, wc, fr, fq); S.done(cur); }
        if (!has_next) break;
#pragma unroll
        for (int a = 0; a < 2; ++a)
#pragma unroll
            for (int b = 0; b < 2; ++b)
#pragma unroll
                for (int m = 0; m < 4; ++m)
#pragma unroll
                    for (int n = 0; n < 2; ++n) acc[a][b][m][n] = (f32x4){0.f, 0.f, 0.f, 0.f};
        cur = nxt; cA = nA; cB = nB; ++ui;
        if constexpr (ALIGN_EPI) { if (wr == 1) PG8_BAR; }
    }
    PG8_WAIT_V(0);
    if constexpr (!ALIGN_EPI) { if (wr == 0) PG8_BAR; }
    PG8_BAR;
    if constexpr (Epi::AFTER_DRAIN) { E.fused(acc, cur, wr, wc, fr, fq, lds, wid, lane); S.done(cur); }
#undef PG8_SA
#undef PG8_SB
#undef PG8_STAGE
#undef PG8_LDA
#undef PG8_LDB
#undef PG8_MMA
#undef PG8_WAIT_V
#undef PG8_WAIT_L
#undef PG8_BAR
#undef PG8_SCHED
}
}
#ifndef GEMM_ALIGN
#define GEMM_ALIGN true
#endif
#ifndef GEMM_SP2
#define GEMM_SP2 true
#endif
typedef unsigned short bf16;
typedef float f32x4 __attribute__((ext_vector_type(4)));
typedef float f32x16 __attribute__((ext_vector_type(16)));
typedef short bf16x8 __attribute__((ext_vector_type(8)));
typedef unsigned u32x4 __attribute__((ext_vector_type(4)));
typedef unsigned u32x2 __attribute__((ext_vector_type(2)));
#define LAS __attribute__((address_space(3)))
#define DI __device__ __forceinline__

constexpr int D = 1024, NTOK = 65536, HTOK = 32768, DFF = 2816, NW = 8;
constexpr float EPS = 1e-6f, LOG2E = 1.4426950408889634f;
constexpr size_t MiB = (size_t)1 << 20;
constexpr size_t WS_LB = 0;
constexpr size_t WS_ROPE = 64 * 1024;
constexpr size_t WS_PTR = 512 * 1024;
constexpr size_t WS_BAR = 1 * MiB;
constexpr size_t WS_W1 = 2 * MiB;
constexpr size_t WS_W2 = 90 * MiB;
constexpr size_t WS_HGIN = 134 * MiB;
constexpr size_t WS_HGO = 154 * MiB;
constexpr size_t WS_SWQKV = 158 * MiB;
constexpr size_t WS_SWO = 161 * MiB;
constexpr size_t WS_NAQKV = 163 * MiB;
constexpr size_t WS_NAO = 169 * MiB;
constexpr size_t WS_SSQ = 172 * MiB;
constexpr size_t WS_XN = 176 * MiB;
constexpr size_t WS_AR = 304 * MiB;
constexpr size_t AR_VT = 256 * MiB, AR_OB = 320 * MiB;
constexpr size_t WS_NEED = 704 * MiB;
constexpr int LDS_BYTES = 131072 + 24576;

typedef float f32x2_t __attribute__((ext_vector_type(2))); typedef __bf16 bf16x2_t __attribute__((ext_vector_type(2)));
DI unsigned cvtpk(float lo, float hi) { const f32x2_t v = {lo, hi}; const bf16x2_t b = __builtin_convertvector(v, bf16x2_t); return __builtin_bit_cast(unsigned, b); }
DI float bf2f(unsigned short b) { return __uint_as_float((unsigned)b << 16); }
DI float bflo(unsigned w) { return __uint_as_float(w << 16); }
DI float bfhi(unsigned w) { return __uint_as_float(w & 0xffff0000u); }
DI unsigned short f2bf(float f) { return (unsigned short)(cvtpk(f, 0.f) & 0xffffu); }
DI float h2f(unsigned short h) { return (float)__builtin_bit_cast(_Float16, h); }
DI float wave_sum(float v) {
#pragma unroll
    for (int o = 1; o < 64; o <<= 1) v += __shfl_xor(v, o);
    return v;
}
DI int imin(int a, int b) { return a < b ? a : b; }
DI int imax(int a, int b) { return a > b ? a : b; }
DI int iclamp(int v, int lo, int hi) { return imin(imax(v, lo), hi); }

DI void transpose_item(const float* W, int K, int N, bf16* WT, int item, int lane, bool swiglu, const float* gk) {
    const int nblk = N / 64, kb = item / nblk, nb = item % nblk, k0 = 64 * kb, n0 = 64 * nb;
    int r0 = n0;
    if (swiglu) { r0 = (n0 < DFF) ? (n0 / 128) * 256 + (n0 % 128) : ((n0 - DFF) / 128) * 256 + 128 + ((n0 - DFF) % 128); }
    const float* src = W + (size_t)k0 * N + n0 + lane;
    bf16* dst = WT + (size_t)(r0 + lane) * K + k0;
    float v[64];
#pragma unroll
    for (int j = 0; j < 64; ++j) v[j] = __builtin_nontemporal_load(src + (size_t)j * N);
    if (gk) {
#pragma unroll
        for (int j = 0; j < 64; ++j) v[j] *= gk[k0 + j];
    }
#pragma unroll
    for (int c = 0; c < 8; ++c) { u32x4 o; o.x = cvtpk(v[8 * c], v[8 * c + 1]); o.y = cvtpk(v[8 * c + 2], v[8 * c + 3]); o.z = cvtpk(v[8 * c + 4], v[8 * c + 5]); o.w = cvtpk(v[8 * c + 6], v[8 * c + 7]);
        *(u32x4*)(dst + 8 * c) = o; }
}
struct In { const float *xp, *xs, *norm_g, *fin_g, *w1, *w2, *hg_in, *hg_o, *hg_gn, *hg_lb, *sw_qkv, *sw_o, *sw_sink, *na_qkv, *na_o, *na_rpb; };
struct Args { In in; float* out; unsigned char* ws; double inv[8]; int lo, hi; };

DI void conv_phase(const In& I, unsigned char* ws, const double* inv, unsigned char* lds, int tid) {
    const int lane = tid & 63, wave = tid >> 6;
    const int gw = blockIdx.x * NW + wave, ngw = gridDim.x * NW;
    constexpr int I_W1 = 16 * 88, I_W2 = 44 * 16, I_HGIN = 16 * 80, I_SQ = 16 * 16, I_SWQ = 16 * 24, I_NAQ = 16 * 48;
    constexpr int NIT = 8 * I_W1 + 8 * I_W2 + 2 * I_HGIN + 2 * I_SQ + I_SWQ + I_SQ + I_NAQ + I_SQ;
    for (int it = gw; it < NIT; it += ngw) {
        int r = it;
        if (r < 8 * I_W1) { const int m = r / I_W1; transpose_item(I.w1 + (size_t)m * D * 2 * DFF, D, 2 * DFF, (bf16*)(ws + WS_W1) + (size_t)m * 2 * DFF * D, r % I_W1, lane, true, I.norm_g + ((m >> 1) * 3 + (m & 1) * 2) * D); continue; } r -= 8 * I_W1;
        if (r < 8 * I_W2) { const int m = r / I_W2; transpose_item(I.w2 + (size_t)m * DFF * D, DFF, D, (bf16*)(ws + WS_W2) + (size_t)m * D * DFF, r % I_W2, lane, false, nullptr); continue; } r -= 8 * I_W2;
        if (r < 2 * I_HGIN) { const int m = r / I_HGIN; transpose_item(I.hg_in + (size_t)m * D * 5 * D, D, 5 * D, (bf16*)(ws + WS_HGIN) + (size_t)m * 5 * D * D, r % I_HGIN, lane, false, I.norm_g + (m * 9 + 1) * D); continue; } r -= 2 * I_HGIN;
        if (r < 2 * I_SQ) { const int m = r / I_SQ; transpose_item(I.hg_o + (size_t)m * D * D, D, D, (bf16*)(ws + WS_HGO) + (size_t)m * D * D, r % I_SQ, lane, false, nullptr); continue; } r -= 2 * I_SQ;
        if (r < I_SWQ) { transpose_item(I.sw_qkv, D, 1536, (bf16*)(ws + WS_SWQKV), r, lane, false, I.norm_g + 4 * D); continue; } r -= I_SWQ;
        if (r < I_SQ) { transpose_item(I.sw_o, D, D, (bf16*)(ws + WS_SWO), r, lane, false, nullptr); continue; } r -= I_SQ;
        if (r < I_NAQ) { transpose_item(I.na_qkv, D, 3072, (bf16*)(ws + WS_NAQKV), r, lane, false, I.norm_g + 7 * D); continue; } r -= I_NAQ;
        transpose_item(I.na_o, D, D, (bf16*)(ws + WS_NAO), r, lane, false, nullptr);
    }
    const int gt = blockIdx.x * 512 + tid, ngt = gridDim.x * 512;
    float* lbt = (float*)(ws + WS_LB);
    for (int i = gt; i < 2048; i += ngt) { const int d = i >> 10, c = i & 1023;
        float v[4], mx = -1e30f;
        for (int l = 0; l < 4; ++l) { v[l] = I.hg_lb[(d * 4 + l) * 1024 + c]; mx = fmaxf(mx, v[l]); }
        float s = 0.f; for (int l = 0; l < 4; ++l) { v[l] = __expf(v[l] - mx); s += v[l]; }
        float cum = 0.f; lbt[(0 * 2 + d) * 1024 + c] = 0.f;
        for (int l = 1; l < 4; ++l) { cum += v[l] / s; lbt[(l * 2 + d) * 1024 + c] = cum; } }
    float* rt = (float*)(ws + WS_ROPE);
    for (int i = gt; i < 4096 * 8; i += ngt) { const int pos = i >> 3, j = i & 7;
        const double ang = (double)pos * inv[j]; const double TWO_PI = 6.283185307179586476925;
        const double r = ang - TWO_PI * __builtin_rint(ang / TWO_PI), r2 = r * r;
        double ts = r, sn = r, tc = 1.0, cs = 1.0;
        for (int n = 1; n <= 13; ++n) { ts *= -r2 / (double)((2 * n) * (2 * n + 1)); sn += ts; tc *= -r2 / (double)((2 * n - 1) * (2 * n)); cs += tc; }
        rt[pos * 16 + j] = (float)cs; rt[pos * 16 + 8 + j] = (float)sn; }
}

DI void first_phase(const float* xp, const float* xs, bf16* XB, float* ssq, int tid) {
    const int lane = tid & 63, wave = tid >> 6;
    const int gw = blockIdx.x * NW + wave, ngw = gridDim.x * NW;
    for (int row = gw; row < NTOK; row += ngw) {
        const float* src = row < HTOK ? xp + (size_t)row * D : xs + (size_t)(row - HTOK) * D;
        const f32x4* xr = (const f32x4*)src + lane;
        f32x4 v[4]; float ss = 0.f;
#pragma unroll
        for (int j = 0; j < 4; ++j) { v[j] = __builtin_nontemporal_load(xr + 64 * j); ss += (v[j].x * v[j].x + v[j].y * v[j].y) + (v[j].z * v[j].z + v[j].w * v[j].w); }
        ss = wave_sum(ss);
        u32x2* o = (u32x2*)(XB + (size_t)row * D) + lane;
#pragma unroll
        for (int j = 0; j < 4; ++j) { u32x2 w; w.x = cvtpk(v[j].x, v[j].y); w.y = cvtpk(v[j].z, v[j].w); o[64 * j] = w; }
        if (lane < 16) ssq[(size_t)row * 16 + lane] = (lane == 0) ? ss : 0.f;
    }
}
DI void final_phase(const bf16* XB, const float* ssq, const float* g, float* out, int tid) {
    const int lane = tid & 63, wave = tid >> 6;
    const int gw = blockIdx.x * NW + wave, ngw = gridDim.x * NW;
    f32x4 gv[4];
#pragma unroll
    for (int j = 0; j < 4; ++j) gv[j] = ((const f32x4*)g)[64 * j + lane];
    for (int row = gw; row < NTOK; row += ngw) {
        const float rstd = pg8::rstd_row(ssq, row);
        const u32x2* xr = (const u32x2*)(XB + (size_t)row * D) + lane;
        f32x4* o = (f32x4*)(out + (size_t)row * D) + lane;
#pragma unroll
        for (int j = 0; j < 4; ++j) { const u32x2 w = __builtin_nontemporal_load(xr + 64 * j); const f32x4 v = {bflo(w.x), bfhi(w.x), bflo(w.y), bfhi(w.y)}; __builtin_nontemporal_store(v * rstd * gv[j], o + 64 * j); }
    }
}

DI void seq_of(int row, int& base, int& len) { if (row < HTOK) { len = 4096; base = row & ~4095; } else { len = 2048; base = HTOK + ((row - HTOK) & ~2047); } }

DI void rope_phase(bf16* QK, const float* rt, int tid) {
    const int gt = blockIdx.x * 512 + tid, ngt = gridDim.x * 512;
    for (int i = gt; i < NTOK * 20; i += ngt) { const int row = i / 20, hd = i % 20;
        int base, len; seq_of(row, base, len); const int pos = row - base;
        u32x4* p = (u32x4*)(QK + (size_t)row * 1280 + hd * 64);
        const u32x4 a = p[0], b = p[1];
        const f32x4* t = (const f32x4*)(rt + pos * 16); const f32x4 c0 = t[0], c1 = t[1], s0 = t[2], s1 = t[3];
        const float cs[8] = {c0.x, c0.y, c0.z, c0.w, c1.x, c1.y, c1.z, c1.w}, sn[8] = {s0.x, s0.y, s0.z, s0.w, s1.x, s1.y, s1.z, s1.w};
        const unsigned aw[4] = {a.x, a.y, a.z, a.w}, bw[4] = {b.x, b.y, b.z, b.w};
        unsigned oa[4], ob[4];
#pragma unroll
        for (int w = 0; w < 4; ++w) {
            const float x1l = bflo(aw[w]), x1h = bfhi(aw[w]), x2l = bflo(bw[w]), x2h = bfhi(bw[w]);
            oa[w] = cvtpk(x1l * cs[2 * w] - x2l * sn[2 * w], x1h * cs[2 * w + 1] - x2h * sn[2 * w + 1]);
            ob[w] = cvtpk(x2l * cs[2 * w] + x1l * sn[2 * w], x2h * cs[2 * w + 1] + x1h * sn[2 * w + 1]); }
        p[0] = (u32x4){oa[0], oa[1], oa[2], oa[3]}; p[1] = (u32x4){ob[0], ob[1], ob[2], ob[3]};
    }
}

DI int crow(int r, int hi) { return (r & 3) + 8 * (r >> 2) + 4 * hi; }
#define MFMA32(a, b, c) __builtin_amdgcn_mfma_f32_32x32x16_bf16((a), (b), (c), 0, 0, 0)
struct KVFrag { bf16x8 k[4]; bf16x8 v[2][2]; };
DI int kperm(int i) { return (i & 0x13) | ((i & 4) << 1) | ((i & 8) >> 1); }
DI int kidx(int r, int hi) { return (r & 7) + 8 * hi + 16 * (r >> 3); }
DI void kv_load(KVFrag& f, const bf16* Kp  , int ldq, const bf16* Vp  , int tok0, int l32) {
    const bf16* kr = Kp + (size_t)(tok0 + kperm(l32)) * ldq;
#pragma unroll
    for (int s = 0; s < 4; ++s) f.k[s] = *(const bf16x8*)(kr + 16 * s);
#pragma unroll
    for (int dt = 0; dt < 2; ++dt)
#pragma unroll
        for (int ks = 0; ks < 2; ++ks) f.v[dt][ks] = *(const bf16x8*)(Vp + (size_t)dt * 32 * NTOK + tok0 + 16 * ks);
}
template <class F> DI void tile_math(const bf16* Kl, const bf16* Vl, int vs, const F& f, const bf16x8 (&qf)[4], float& m, float& l, f32x16& o0, f32x16& o1, int l32, int hi) {
    bf16x8 kf[4], vf[2][2];
    const bf16* kr = Kl + kperm(l32) * 72 + 8 * hi;
#pragma unroll
    for (int s = 0; s < 4; ++s) kf[s] = *(const bf16x8*)(kr + 16 * s);
#pragma unroll
    for (int dt = 0; dt < 2; ++dt)
#pragma unroll
        for (int ks = 0; ks < 2; ++ks) vf[dt][ks] = *(const bf16x8*)(Vl + (32 * dt + l32) * vs + 16 * ks + 8 * hi);
    f32x16 s = {};
#pragma unroll
    for (int st = 0; st < 4; ++st) s = MFMA32(kf[st], qf[st], s);
    float tmax = -INFINITY;
    if (f.full()) {
#pragma unroll
        for (int r = 0; r < 16; ++r) { s[r] *= (0.125f * LOG2E); tmax = fmaxf(tmax, s[r]); }
    } else {
#pragma unroll
        for (int r = 0; r < 16; ++r) { s[r] = f.score(r, s[r]); tmax = fmaxf(tmax, s[r]); }
    }
    { const auto rr = __builtin_amdgcn_permlane32_swap(__float_as_uint(tmax), __float_as_uint(tmax), false, false); tmax = fmaxf(__uint_as_float(rr[0]), __uint_as_float(rr[1])); }
    if (__ballot(tmax > m + 8.0f) != 0ull) {
        const float mn = fmaxf(m, tmax), fs = __builtin_amdgcn_exp2f(m - mn);
        l *= fs; m = mn;
#pragma unroll
        for (int r = 0; r < 16; ++r) { o0[r] *= fs; o1[r] *= fs; }
    }
    float ps = 0.f;
#pragma unroll
    for (int r = 0; r < 16; ++r) { s[r] = __builtin_amdgcn_exp2f(s[r] - m); ps += s[r]; }
    l += ps;
#pragma unroll
    for (int ks = 0; ks < 2; ++ks) {
        u32x4 pw; pw.x = cvtpk(s[8 * ks], s[8 * ks + 1]); pw.y = cvtpk(s[8 * ks + 2], s[8 * ks + 3]); pw.z = cvtpk(s[8 * ks + 4], s[8 * ks + 5]); pw.w = cvtpk(s[8 * ks + 6], s[8 * ks + 7]);
        const bf16x8 pb = __builtin_bit_cast(bf16x8, pw);
        o0 = MFMA32(vf[0][ks], pb, o0);
        o1 = MFMA32(vf[1][ks], pb, o1);
    }
}
DI void attn_store(bf16* AO, int qtok, int ocol, const f32x16& o0, const f32x16& o1, float l, int hi) {
    l += __shfl_xor(l, 32);
    const float rl = 1.0f / l;
    bf16* op = AO + (size_t)qtok * D + ocol + 4 * hi;
#pragma unroll
    for (int g = 0; g < 4; ++g) {
        u32x2 w0, w1; w0.x = cvtpk(o0[4 * g] * rl, o0[4 * g + 1] * rl); w0.y = cvtpk(o0[4 * g + 2] * rl, o0[4 * g + 3] * rl);
        w1.x = cvtpk(o1[4 * g] * rl, o1[4 * g + 1] * rl); w1.y = cvtpk(o1[4 * g + 2] * rl, o1[4 * g + 3] * rl);
        *(u32x2*)(op + 8 * g) = w0; *(u32x2*)(op + 32 + 8 * g) = w1; }
}
DI u32x4 rope8(u32x4 mine, u32x4 other, const float* cs, bool lo) {
    const f32x4 c0 = *(const f32x4*)cs, c1 = *(const f32x4*)(cs + 4), s0 = *(const f32x4*)(cs + 8), s1 = *(const f32x4*)(cs + 12);
    const float c[8] = {c0.x, c0.y, c0.z, c0.w, c1.x, c1.y, c1.z, c1.w}, s[8] = {s0.x, s0.y, s0.z, s0.w, s1.x, s1.y, s1.z, s1.w};
    const unsigned mw[4] = {mine.x, mine.y, mine.z, mine.w}, ow[4] = {other.x, other.y, other.z, other.w};
    unsigned o[4];
#pragma unroll
    for (int w = 0; w < 4; ++w) {
        const float ml = bflo(mw[w]), mh = bfhi(mw[w]), ol = bflo(ow[w]), oh = bfhi(ow[w]);
        const float sl = lo ? -s[2 * w] : s[2 * w], sh = lo ? -s[2 * w + 1] : s[2 * w + 1];
        o[w] = cvtpk(ml * c[2 * w] + ol * sl, mh * c[2 * w + 1] + oh * sh); }
    return (u32x4){o[0], o[1], o[2], o[3]};
}
DI u32x4 shfl4(u32x4 v, int mask) { return (u32x4){(unsigned)__shfl_xor((int)v.x, mask), (unsigned)__shfl_xor((int)v.y, mask), (unsigned)__shfl_xor((int)v.z, mask), (unsigned)__shfl_xor((int)v.w, mask)}; }
struct SwaF {
    int dbase; bool fullt;
    DI bool full() const { return fullt; }
    DI float score(int r, float raw) const { const int d = dbase + (r & 7) + 16 * (r >> 3); return (d <= 128 && d >= -128) ? raw * (0.125f * LOG2E) : -INFINITY; }
};
DI void swa_phase(const bf16* QK, const bf16* VT, bf16* AO, const float* sinks, const float* rt, unsigned char* lds, int tid) {
    const int lane = tid & 63, wave = tid >> 6, l32 = lane & 31, hi = lane >> 5;
    constexpr int KB = 32 * 72, VS = 40, TB = KB + 64 * VS;
    bf16* T = (bf16*)lds;
    const int qblk = wave >> 2;
    for (int u = blockIdx.x; u < (NTOK / 64) * 4; u += gridDim.x) {
        const int row0 = (u >> 2) * 64, kvh = u & 3, hq = kvh * 4 + (wave & 3);
        int sb, len; seq_of(row0, sb, len); const int q0 = row0 - sb;
        const int t0 = (q0 < 128) ? (128 - q0) / 32 : 0, t1 = imin(9, (len - 1 - (q0 - 128)) / 32);
        const int qtok = row0 + 32 * qblk + l32, qpos = q0 + 32 * qblk + l32;
        bf16x8 qf[4];
        { const bf16* qp = QK + (size_t)qtok * 1280 + hq * 64 + 8 * hi;
#pragma unroll
          for (int s = 0; s < 4; ++s) qf[s] = *(const bf16x8*)(qp + 16 * s); }
        { const u32x4 mine = __builtin_bit_cast(u32x4, qf[0]); qf[0] = __builtin_bit_cast(bf16x8, rope8(mine, shfl4(mine, 32), rt + qpos * 16, hi == 0)); }
        float m = sinks[hq] * LOG2E, l = hi ? 0.f : 1.f; f32x16 o0 = {}, o1 = {};
        const bool isk = tid < 256; const int sr = isk ? (tid >> 3) : ((tid - 256) >> 2), sp = isk ? (tid & 7) : (tid & 3);
        const bf16* gsrc = isk ? QK + (size_t)(sb + q0 - 128 + sr) * 1280 + 1024 + kvh * 64 + sp * 8 : VT + (size_t)(kvh * 64 + sr) * NTOK + (sb + q0 - 128) + sp * 8;
        const size_t gstep = isk ? (size_t)32 * 1280 : 32;
        const int ldst = isk ? sr * 72 + sp * 8 : KB + sr * VS + sp * 8;
#define SWA_ROPE(val, t_) do { if (isk) { const u32x4 oth_ = shfl4(val, 1); if (sp < 2) val = rope8(val, oth_, rt + (q0 - 128 + 32 * (t_) + sr) * 16, sp == 0); } } while (0)
        u32x4 stg = *(const u32x4*)(gsrc + (size_t)t0 * gstep);
        SWA_ROPE(stg, t0);
        *(u32x4*)(T + (t0 & 1) * TB + ldst) = stg;
        if (t0 + 1 <= t1) stg = *(const u32x4*)(gsrc + (size_t)(t0 + 1) * gstep);
        __syncthreads();
        for (int t = t0; t <= t1; ++t) {
            if (t + 1 <= t1) { SWA_ROPE(stg, t + 1); *(u32x4*)(T + ((t + 1) & 1) * TB + ldst) = stg; }
            if (t + 2 <= t1) stg = *(const u32x4*)(gsrc + (size_t)(t + 2) * gstep);
            if (t >= qblk && t <= qblk + 8) {
                SwaF f; f.dbase = (q0 - 128 + 32 * t) + 8 * hi - qpos; { const int rel = 32 * (t - qblk) - 128; f.fullt = (rel >= -96) && (rel <= 96); }
                const bf16* tb = T + (t & 1) * TB;
                tile_math(tb, tb + KB, VS, f, qf, m, l, o0, o1, l32, hi);
            }
            __syncthreads();
        }
        attn_store(AO, qtok, hq * 64, o0, o1, l, hi);
    }
#undef SWA_ROPE
}
struct NaF {
    unsigned colmask; int dcl[16]; int qrow, rsq; const float* rpb; const float* rpt; bool rowok;
    DI bool full() const { return false; }
    DI void tile(int R) { rowok = (R >= rsq) && (R < rsq + 8); rpt = rpb + iclamp(R - qrow + 7, 0, 14) * 32; }
    DI float score(int r, float raw) const { const bool ok = rowok && ((colmask >> r) & 1u); return ok ? fmaf(raw, 0.125f * LOG2E, rpt[dcl[r]]) : -INFINITY; }
};
DI void na_phase(const bf16* QK, const bf16* VT, bf16* AO, const float* rpbg, unsigned char* lds, int tid) {
    const int lane = tid & 63, wave = tid >> 6, l32 = lane & 31, hi = lane >> 5;
    constexpr int KB = 64 * 72, VS = 72, TB = KB + 64 * VS;
    float* rp = (float*)lds;
    bf16* T = (bf16*)(lds + 16 * 15 * 32 * 4);
    for (int i = tid; i < 16 * 15 * 32; i += 512) { const int c = i & 31, hr = i >> 5; rp[i] = (c < 31) ? rpbg[hr * 31 + c] * LOG2E : 0.f; }
    __syncthreads();
    const int rpw = wave >> 2, j = wave & 3;
    for (int u = blockIdx.x; u < 4096; u += gridDim.x) {
        const int g = u >> 4, h = u & 15;
        int rows, seqb, quad;
        if (g < 128) { rows = 64; seqb = (g >> 4) * 4096; quad = g & 15; } else { const int g2 = g - 128; rows = 32; seqb = HTOK + (g2 >> 3) * 2048; quad = g2 & 7; }
        const int r0 = 4 * quad, RA = iclamp(r0 - 4, 0, rows - 8), RB = iclamp(r0 - 1, 0, rows - 8) + 7;
        const int rw = r0 + 2 * rpw, wA = iclamp(rw - 4, 0, rows - 8), wB = iclamp(rw - 3, 0, rows - 8) + 7;
        const int cst = iclamp(16 * j - 8, 0, 32);
        NaF f; f.qrow = rw + (l32 >> 4); const int qcol = 16 * j + (l32 & 15); f.rsq = iclamp(f.qrow - 4, 0, rows - 8); const int csq = iclamp(qcol - 8, 0, 48); f.rpb = rp + h * 15 * 32;
        { unsigned cm = 0u;
#pragma unroll
          for (int r = 0; r < 16; ++r) { const int kc = cst + 8 * hi + (r & 7) + 16 * (r >> 3); cm |= ((kc >= csq) && (kc < csq + 16)) ? (1u << r) : 0u; f.dcl[r] = iclamp(kc - qcol + 15, 0, 30); }
          f.colmask = cm; }
        f.rowok = false; f.rpt = f.rpb;
        const int qtok = seqb + f.qrow * 64 + qcol;
        bf16x8 qf[4];
        { const bf16* qp = QK + (size_t)qtok * 2048 + h * 64 + 8 * hi;
#pragma unroll
          for (int s = 0; s < 4; ++s) qf[s] = *(const bf16x8*)(qp + 16 * s); }
        float m = -1e30f, l = 0.f; f32x16 o0 = {}, o1 = {};
        const int sr = tid >> 3, sp = tid & 7;
        const bf16* gk = QK + (size_t)(seqb + sr) * 2048 + 1024 + h * 64 + sp * 8;
        const bf16* gv = VT + (size_t)(h * 64 + sr) * NTOK + seqb + sp * 8;
        const int lk = sr * 72 + sp * 8, lv = KB + sr * VS + sp * 8;
        u32x4 sk = *(const u32x4*)(gk + (size_t)RA * 64 * 2048), sv = *(const u32x4*)(gv + RA * 64);
        *(u32x4*)(T + (RA & 1) * TB + lk) = sk; *(u32x4*)(T + (RA & 1) * TB + lv) = sv;
        if (RA + 1 <= RB) { sk = *(const u32x4*)(gk + (size_t)(RA + 1) * 64 * 2048); sv = *(const u32x4*)(gv + (RA + 1) * 64); }
        __syncthreads();
        for (int R = RA; R <= RB; ++R) {
            if (R + 1 <= RB) { *(u32x4*)(T + ((R + 1) & 1) * TB + lk) = sk; *(u32x4*)(T + ((R + 1) & 1) * TB + lv) = sv; }
            if (R + 2 <= RB) { sk = *(const u32x4*)(gk + (size_t)(R + 2) * 64 * 2048); sv = *(const u32x4*)(gv + (R + 2) * 64); }
            if (R >= wA && R <= wB) {
                f.tile(R);
                const bf16* tb = T + (R & 1) * TB;
                tile_math(tb + cst * 72, tb + KB + cst, VS, f, qf, m, l, o0, o1, l32, hi);
            }
            __syncthreads();
        }
        attn_store(AO, qtok, h * 64, o0, o1, l, hi);
    }
}

#define MFMA16(a, b, c) __builtin_amdgcn_mfma_f32_16x16x32_bf16((a), (b), (c), 0, 0, 0)
constexpr int SQ = 136, ST = 72;
constexpr int L_QR = 0, L_KR = 17408, L_VRAW = 34816, L_KRT = 52224, L_VT = 70656, L_AM = 89088, L_SPT = 98304, L_SEG = 133120, L_EMID = 135168, L_EEND = 135680;
DI float cexp2(float x) { return __builtin_amdgcn_exp2f(fminf(fmaxf(x, -100.f), 100.f)); }
template <int VS> DI void scan_phase(const bf16* P, bf16* OF, bf16* OB, int half, unsigned char* lds, int tid) {
    constexpr int NVB = VS / 16, VSTR = (VS == 64) ? ST : SQ;
    const int lane = tid & 63, wave = tid >> 6, l16 = lane & 15, rq = lane >> 4;
    const int Tlen = half ? 2048 : 4096, nseq = half ? 16 : 8, NC = Tlen / 64, nitems = nseq * 16 * (128 / VS);
    bf16* QR = (bf16*)(lds + L_QR); bf16* KR = (bf16*)(lds + L_KR); bf16* VRAW = (bf16*)(lds + L_VRAW); bf16* KRT = (bf16*)(lds + L_KRT);
    bf16* VT = (bf16*)(lds + L_VT); bf16* AM = (bf16*)(lds + L_AM); bf16* SPT = (bf16*)(lds + L_SPT);
    float* SEG = (float*)(lds + L_SEG); float* EMID = (float*)(lds + L_EMID); float* EEND = (float*)(lds + L_EEND);
    const int lr = tid >> 3, lc = tid & 7;
    for (int item = blockIdx.x; item < nitems; item += gridDim.x) {
        int vs, dir, h, seq;
        if (VS == 64) { vs = item & 1; dir = (item >> 1) & 1; h = (item >> 2) & 7; seq = item >> 5; } else { vs = 0; dir = item & 1; h = (item >> 1) & 7; seq = item >> 4; }
        const bf16* Pq = P + (size_t)seq * Tlen * 5120 + h * 128;
        const bf16* Pv = Pq + 1024 + vs * VS;
        const bf16* Pl = Pq + 3072 + dir * 1024;
        bf16* Oo = (dir ? OB : OF) + (size_t)seq * Tlen * D + h * 128 + vs * VS;
        f32x4 S[NVB];
#pragma unroll
        for (int i = 0; i < NVB; ++i) S[i] = (f32x4){0.f, 0.f, 0.f, 0.f};
        u32x4 pq0, pq1, pl0, pl1, pv, pv1;
#define SC_TOK(c, tau) (dir ? (Tlen - 1 - ((c) * 64 + (tau))) : ((c) * 64 + (tau)))
#define SC_LOAD(c) do { const size_t ro = (size_t)SC_TOK(c, lr) * 5120; \
            pq0 = *(const u32x4*)(Pq + ro + lc * 8); pq1 = *(const u32x4*)(Pq + ro + 64 + lc * 8); \
            pl0 = *(const u32x4*)(Pl + ro + lc * 8); pl1 = *(const u32x4*)(Pl + ro + 64 + lc * 8); \
            pv = *(const u32x4*)(Pv + ro + lc * 8); if (VS == 128) pv1 = *(const u32x4*)(Pv + ro + 64 + lc * 8); } while (0)
        SC_LOAD(0);
        for (int c = 0; c < NC; ++c) {
            *(u32x4*)(QR + lr * SQ + lc * 8) = pq0; *(u32x4*)(QR + lr * SQ + 64 + lc * 8) = pq1;
            *(u32x4*)(KR + lr * SQ + lc * 8) = pl0; *(u32x4*)(KR + lr * SQ + 64 + lc * 8) = pl1;
            *(u32x4*)(VRAW + lr * VSTR + lc * 8) = pv; if (VS == 128) *(u32x4*)(VRAW + lr * VSTR + 64 + lc * 8) = pv1;
            if (c + 1 < NC) SC_LOAD(c + 1);
            __syncthreads();
            const int k = tid & 127, seg = tid >> 7;
            float lf[16], cs[16]; float run = 0.f; unsigned short lraw[16], qraw[16];
#pragma unroll
            for (int i = 0; i < 16; ++i) lraw[i] = KR[(16 * seg + i) * SQ + k];
#pragma unroll
            for (int i = 0; i < 16; ++i) qraw[i] = QR[(16 * seg + i) * SQ + k];
#pragma unroll
            for (int i = 0; i < 16; ++i) { lf[i] = h2f(lraw[i]); run += lf[i]; cs[i] = run; }
            SEG[seg * 128 + k] = run;
            { constexpr int NR = VS / 8;
              const int v = tid & (VS - 1), ss = tid / VS; unsigned short t[NR];
#pragma unroll
              for (int i = 0; i < NR; ++i) t[i] = VRAW[(NR * ss + i) * VSTR + v];
#pragma unroll
              for (int j = 0; j < NR / 8; ++j) { u32x4 w; w.x = t[8 * j] | ((unsigned)t[8 * j + 1] << 16); w.y = t[8 * j + 2] | ((unsigned)t[8 * j + 3] << 16); w.z = t[8 * j + 4] | ((unsigned)t[8 * j + 5] << 16); w.w = t[8 * j + 6] | ((unsigned)t[8 * j + 7] << 16);
                  *(u32x4*)(VT + v * ST + NR * ss + 8 * j) = w; } }
            __syncthreads();
            { const float t0 = SEG[k], t1 = SEG[128 + k], t2 = SEG[256 + k], t3 = SEG[384 + k];
              const float pre = (seg == 0) ? 0.f : (seg == 1) ? t0 : (seg == 2) ? (t0 + t1) : (t0 + t1 + t2);
              const float bmid = t0 + t1, bend = bmid + t2 + t3;
              unsigned short kb[16];
              float eprev = cexp2(bmid - (pre + cs[0] - lf[0]));
#pragma unroll
              for (int i = 0; i < 16; ++i) { const int tau = 16 * seg + i; const float ecur = cexp2(bmid - (pre + cs[i]));
                  const float qv = bf2f(qraw[i]); QR[tau * SQ + k] = f2bf(qv * __builtin_amdgcn_rcpf(ecur));
                  kb[i] = f2bf(ecur - eprev); KR[tau * SQ + k] = kb[i]; eprev = ecur; }
              u32x4 w0, w1; w0.x = kb[0] | ((unsigned)kb[1] << 16); w0.y = kb[2] | ((unsigned)kb[3] << 16); w0.z = kb[4] | ((unsigned)kb[5] << 16); w0.w = kb[6] | ((unsigned)kb[7] << 16);
              w1.x = kb[8] | ((unsigned)kb[9] << 16); w1.y = kb[10] | ((unsigned)kb[11] << 16); w1.z = kb[12] | ((unsigned)kb[13] << 16); w1.w = kb[14] | ((unsigned)kb[15] << 16);
              *(u32x4*)(KRT + k * ST + 16 * seg) = w0; *(u32x4*)(KRT + k * ST + 16 * seg + 8) = w1;
              if (seg == 0) { EMID[k] = cexp2(bmid); EEND[k] = cexp2(bend - bmid); } }
            __syncthreads();
            { const f32x4 em = *(const f32x4*)(EMID + 16 * wave + 4 * rq);
#pragma unroll
              for (int vb = 0; vb < NVB; ++vb) { S[vb] = S[vb] * em; u32x2 w; w.x = cvtpk(S[vb][0], S[vb][1]); w.y = cvtpk(S[vb][2], S[vb][3]);
                  *(u32x2*)(SPT + (16 * vb + l16) * SQ + 16 * wave + 4 * rq) = w; } }
            { const int tb = wave >> 1;
#pragma unroll
              for (int sbi = 0; sbi < 2; ++sbi) { const int sb = 2 * (wave & 1) + sbi; f32x4 acc = {0.f, 0.f, 0.f, 0.f};
                  if (sb <= tb) {
#pragma unroll
                      for (int st = 0; st < 4; ++st) { const bf16x8 a = *(const bf16x8*)(KR + (16 * sb + l16) * SQ + 8 * rq + 32 * st), b = *(const bf16x8*)(QR + (16 * tb + l16) * SQ + 8 * rq + 32 * st); acc = MFMA16(a, b, acc); }
                      const int t = 16 * tb + l16, s0 = 16 * sb + 4 * rq;
#pragma unroll
                      for (int r = 0; r < 4; ++r) acc[r] = (s0 + r <= t) ? acc[r] : 0.f;
                  }
                  u32x2 w; w.x = cvtpk(acc[0], acc[1]); w.y = cvtpk(acc[2], acc[3]);
                  *(u32x2*)(AM + (16 * tb + l16) * ST + 16 * sb + 4 * rq) = w; } }
            __syncthreads();
            { const int tb = wave >> 1; const size_t orow = (size_t)SC_TOK(c, 16 * tb + l16) * D;
#pragma unroll
              for (int vbi = 0; vbi < NVB / 2; ++vbi) { const int vb = (NVB / 2) * (wave & 1) + vbi; f32x4 acc = {0.f, 0.f, 0.f, 0.f};
#pragma unroll
                  for (int st = 0; st < 4; ++st) { const bf16x8 a = *(const bf16x8*)(SPT + (16 * vb + l16) * SQ + 8 * rq + 32 * st), b = *(const bf16x8*)(QR + (16 * tb + l16) * SQ + 8 * rq + 32 * st); acc = MFMA16(a, b, acc); }
#pragma unroll
                  for (int st = 0; st < 2; ++st) { const bf16x8 a = *(const bf16x8*)(VT + (16 * vb + l16) * ST + 8 * rq + 32 * st), b = *(const bf16x8*)(AM + (16 * tb + l16) * ST + 8 * rq + 32 * st); acc = MFMA16(a, b, acc); }
                  u32x2 w; w.x = cvtpk(acc[0], acc[1]); w.y = cvtpk(acc[2], acc[3]);
                  *(u32x2*)(Oo + orow + 16 * vb + 4 * rq) = w; } }
            { const bf16x8 a0 = *(const bf16x8*)(KRT + (16 * wave + l16) * ST + 8 * rq), a1 = *(const bf16x8*)(KRT + (16 * wave + l16) * ST + 8 * rq + 32);
              const f32x4 ee = *(const f32x4*)(EEND + 16 * wave + 4 * rq);
#pragma unroll
              for (int vb = 0; vb < NVB; ++vb) { const bf16x8 b0 = *(const bf16x8*)(VT + (16 * vb + l16) * ST + 8 * rq), b1 = *(const bf16x8*)(VT + (16 * vb + l16) * ST + 8 * rq + 32);
                  S[vb] = MFMA16(a0, b0, S[vb]); S[vb] = MFMA16(a1, b1, S[vb]); S[vb] = S[vb] * ee; } }
            __syncthreads();
        }
#undef SC_LOAD
#undef SC_TOK
    }
}
DI void combine_phase(const bf16* OF, const bf16* OB, const bf16* P, const float* gn, bf16* AOh, int tid) {
    const int lane = tid & 63, wave = tid >> 6, gw = blockIdx.x * NW + wave, ngw = gridDim.x * NW;
    float gv[16];
#pragma unroll
    for (int i = 0; i < 16; ++i) gv[i] = gn[16 * lane + i];
    for (int row = gw; row < HTOK; row += ngw) {
        const u32x4* pf = (const u32x4*)(OF + (size_t)row * D + 16 * lane); const u32x4* pb = (const u32x4*)(OB + (size_t)row * D + 16 * lane);
        const u32x4* pg = (const u32x4*)(P + (size_t)row * 5120 + 2048 + 16 * lane);
        const u32x4 f0 = __builtin_nontemporal_load(pf), f1 = __builtin_nontemporal_load(pf + 1), b0 = __builtin_nontemporal_load(pb), b1 = __builtin_nontemporal_load(pb + 1), g0 = __builtin_nontemporal_load(pg), g1 = __builtin_nontemporal_load(pg + 1);
        const unsigned fw[8] = {f0.x, f0.y, f0.z, f0.w, f1.x, f1.y, f1.z, f1.w}, bw[8] = {b0.x, b0.y, b0.z, b0.w, b1.x, b1.y, b1.z, b1.w}, gw8[8] = {g0.x, g0.y, g0.z, g0.w, g1.x, g1.y, g1.z, g1.w};
        float o[16]; float ss = 0.f;
#pragma unroll
        for (int i = 0; i < 8; ++i) { o[2 * i] = bflo(fw[i]) + bflo(bw[i]); o[2 * i + 1] = bfhi(fw[i]) + bfhi(bw[i]); ss += o[2 * i] * o[2 * i] + o[2 * i + 1] * o[2 * i + 1]; }
        ss += __shfl_xor(ss, 1); ss += __shfl_xor(ss, 2); ss += __shfl_xor(ss, 4);
        const float rstd = 1.0f / sqrtf(ss * (1.0f / 128.0f) + EPS);
        unsigned ow[8];
#pragma unroll
        for (int i = 0; i < 8; ++i) { const float ga = bflo(gw8[i]), gb = bfhi(gw8[i]);
            const float ya = o[2 * i] * rstd * gv[2 * i] * (ga * pg8::fast_sigmoid(ga)), yb = o[2 * i + 1] * rstd * gv[2 * i + 1] * (gb * pg8::fast_sigmoid(gb));
            ow[i] = cvtpk(ya, yb); }
        u32x4* po = (u32x4*)(AOh + (size_t)row * D + 16 * lane);
        po[0] = (u32x4){ow[0], ow[1], ow[2], ow[3]}; po[1] = (u32x4){ow[4], ow[5], ow[6], ow[7]};
    }
}

#define XB_TMO      128
#define XB_XCNT(j)  (256  + 64 * (j))
#define XB_XSUB(j)  (1280 + 64 * (j))
#define XB_XGEN(j)  (2304 + 64 * (j))
#define XB_TOP      3328
#define XB_TOPGEN   3392
#define XCD_BAR_WORDS 3456
#define XB_SPIN_CAP (1u << 18)

__device__ __forceinline__ unsigned xb_ld(unsigned* p)              { return __hip_atomic_load(p, __ATOMIC_RELAXED, __HIP_MEMORY_SCOPE_AGENT); }
__device__ __forceinline__ unsigned xb_add(unsigned* p, unsigned v) { return __hip_atomic_fetch_add(p, v, __ATOMIC_RELAXED, __HIP_MEMORY_SCOPE_AGENT); }
__device__ __forceinline__ unsigned xb_xcc_id() { return (unsigned)__builtin_amdgcn_s_getreg((3 << 11) | 20) & 0xFu; }
#define XB_SPIN(cond, bar) do { unsigned _sp = 0; while (cond) { __builtin_amdgcn_s_sleep(1); \
    if ((++_sp & 255u) == 0u) { if (xb_ld(&(bar)[XB_TMO])) break; if (_sp > XB_SPIN_CAP) { atomicAdd(&(bar)[XB_TMO], 1u); break; } } } } while (0)

struct XcdBarrier {
    unsigned* bar; unsigned x;
    volatile LAS unsigned* st;
};

__device__ __forceinline__ XcdBarrier xcd_barrier_post(unsigned* bar, volatile LAS unsigned* st) {
    XcdBarrier b; b.bar = bar; b.x = xb_xcc_id(); b.st = st;
    if (threadIdx.x == 0) (void)xb_add(&bar[XB_XCNT(b.x)], 1u);
    return b;
}
__device__ __forceinline__ void xcd_barrier_complete(unsigned* bar, unsigned x, unsigned& nloc, unsigned& nx) {
    const unsigned G = gridDim.x * gridDim.y * gridDim.z;
    unsigned sum, cnt, mine, sp = 0u;
    for (;;) {
        sum = 0u; cnt = 0u; mine = 0u;
#pragma unroll
        for (unsigned j = 0; j < 16; ++j) { const unsigned c = xb_ld(&bar[XB_XCNT(j)]); sum += c; cnt += (c > 0u) ? 1u : 0u; mine = (j == x) ? c : mine; }
        if (sum == G) break;
        __builtin_amdgcn_s_sleep(1);
        if ((++sp & 255u) == 0u) { if (xb_ld(&bar[XB_TMO])) break; if (sp > XB_SPIN_CAP) { atomicAdd(&bar[XB_TMO], 1u); break; } }
    }
    nloc = mine > 0u ? mine : 1u; nx = cnt > 0u ? cnt : 1u;
}

__device__ __forceinline__ void xcd_barrier(const XcdBarrier& b) {
    asm volatile("s_waitcnt vmcnt(0)" ::: "memory");
    __syncthreads();
    if (threadIdx.x == 0) {
        unsigned* bar = b.bar;
        __builtin_amdgcn_s_waitcnt(0);
        unsigned nloc = b.st[0], nx = b.st[1];
        if (nloc == 0u) { xcd_barrier_complete(bar, b.x, nloc, nx); b.st[0] = nloc; b.st[1] = nx; }
        const unsigned old = xb_add(&bar[XB_XSUB(b.x)], 1u);
        const unsigned gen = old / nloc;
        if (old + 1u == (gen + 1u) * nloc) {
            __builtin_amdgcn_fence(__ATOMIC_RELEASE, "agent");
            asm volatile("s_waitcnt vmcnt(0)" ::: "memory");
            const unsigned og = xb_add(&bar[XB_TOP], 1u);
            const unsigned tg = og / nx;
            if (og + 1u == (tg + 1u) * nx) xb_add(&bar[XB_TOPGEN], 1u);
            else XB_SPIN(xb_ld(&bar[XB_TOPGEN]) == tg, bar);
            __builtin_amdgcn_fence(__ATOMIC_ACQUIRE, "agent");
            xb_add(&bar[XB_XGEN(b.x)], 1u);
            asm volatile("s_waitcnt vmcnt(0)" ::: "memory");
        } else {
            XB_SPIN(xb_ld(&bar[XB_XGEN(b.x)]) == gen, bar);
            __builtin_amdgcn_fence(__ATOMIC_ACQUIRE, "agent");
            asm volatile("s_waitcnt vmcnt(0)" ::: "memory");
        }
    }
    __syncthreads();
}

template <bool COLS> DI const float* prep_rstd(unsigned char* lds, const float* ssq, int M, int N, int tid) {
    float* tab = (float*)(lds + 131072); int* list = (int*)(lds + 131072 + 23552);
    int bx = blockIdx.x; asm volatile("" : "+s"(bx));
    pg8::StaticOrder S; S.init(M, N, (int)gridDim.x, bx); pg8::Unit u;
    int n = 0;
    for (int i = 0; S.next(i, u); ++i) { if (tid == 0) list[i] = COLS ? u.pn : u.pm; ++n; }
    __syncthreads();
#pragma unroll 4
    for (int e = tid; e < n * 256; e += 512) tab[e] = pg8::rstd_row(ssq, list[e >> 8] * 256 + (e & 255));
    __syncthreads();
    return tab;
}
DI void stagger(int slots, int ticks) {
    const int k = (int)(blockIdx.x >> 3) % slots;
    if (k) { const unsigned long long t0 = __builtin_amdgcn_s_memrealtime(); while (__builtin_amdgcn_s_memrealtime() - t0 < (unsigned long long)(k * ticks)) __builtin_amdgcn_s_sleep(8); }
}
template <class Epi> DI void run_gemm(unsigned char* lds, const bf16* A, const bf16* Bt, int M, int N, int K, const Epi& E, int tid) {
    int bx = blockIdx.x; asm volatile("" : "+s"(bx));
    pg8::Gemm g{A, Bt, M, N, K}; pg8::StaticOrder S; S.init(M, N, (int)gridDim.x, bx);
    pg8::gemm_phase<Epi, pg8::StaticOrder, GEMM_ALIGN, GEMM_SP2>((LAS unsigned char*)lds, g, S, E, tid);
    __syncthreads();
}

__global__ void __launch_bounds__(512, 2) fwd(Args a) {
    extern __shared__ __attribute__((aligned(16))) unsigned char lds[];
    cg::grid_group grid = cg::this_grid();
    volatile LAS unsigned* bst = (volatile LAS unsigned*)((LAS unsigned char*)lds + LDS_BYTES - 16);
    if (threadIdx.x < 2) bst[threadIdx.x] = 0u;
    __syncthreads();
    const XcdBarrier xbar = xcd_barrier_post((unsigned*)(a.ws + WS_BAR), bst);
    unsigned char* ws0 = a.ws;
    const In& I = a.in;
    const int lo = a.lo, hi = a.hi;
    int pc = 0;
#ifndef REP_NORM
#define REP_NORM 1
#endif
#ifndef REP_SCAN
#define REP_SCAN 1
#endif
#ifndef REP_ATTN
#define REP_ATTN 1
#endif
#ifndef REP_FFN1
#define REP_FFN1 1
#endif
#define PTR(k) (((const float* const*)(ws + WS_PTR))[k])
#ifndef STAG_SLOTS
#define STAG_SLOTS 1
#endif
#ifndef STAG_TICKS
#define STAG_TICKS 800
#endif
#ifndef REP_FFN2
#define REP_FFN2 1
#endif
#ifndef REP_HG
#define REP_HG 1
#endif
#ifndef GEMM_SP2
#define GEMM_SP2 true
#endif
#ifndef REP_MISC
#define REP_MISC 1
#endif
#ifndef REP_WO
#define REP_WO 1
#endif
#ifndef REP_SYNC
#define REP_SYNC 1
#endif
#define PH_BEGIN if (pc >= lo && pc < hi) { int tid = threadIdx.x; asm volatile("" : "+v"(tid)); unsigned char* ws = ws0; asm volatile("" : "+s"(ws)); bf16* XB = (bf16*)(ws + WS_XN); bf16* AR = (bf16*)(ws + WS_AR); float* SSQ = (float*)(ws + WS_SSQ); bf16* AO = AO0; asm volatile("" : "+s"(AO)); bf16* OF = AO + (size_t)NTOK * D; bf16* OB = OF + (size_t)HTOK * D; bf16* VT = (bf16*)(ws + WS_AR + AR_VT);
#define PH_END if (pc + 1 < hi) { for (int rs_ = 0; rs_ < REP_SYNC; ++rs_) { if (pc == 0) grid.sync(); else xcd_barrier(xbar); } } } ++pc;

    bf16* AO0 = (bf16*)a.out;
    PH_BEGIN if (blockIdx.x == 0 && tid == 0) { const float** pt = (const float**)(ws + WS_PTR); pt[0] = I.hg_gn; pt[1] = I.sw_sink; pt[2] = I.na_rpb; pt[3] = I.fin_g; }
             for (int rp_ = 0; rp_ < REP_MISC; ++rp_) { conv_phase(I, ws, a.inv, lds, tid); first_phase(I.xp, I.xs, XB, SSQ, tid); } PH_END
    for (int li = 0; li < 4; ++li) {
        for (int sub = 0; sub < 3; ++sub) {
            if (sub != 1) {
                const int fi = li * 2 + (sub >> 1);
                #ifdef SPLIT_FFN1
                PH_BEGIN for (int hh_ = 0; hh_ < 2; ++hh_) { pg8::EpiSwiglu E{AR + (size_t)hh_ * HTOK * DFF, DFF, prep_rstd<false>(lds, SSQ + (size_t)hh_ * HTOK * 16, HTOK, 2 * DFF, tid)}; run_gemm(lds, XB + (size_t)hh_ * HTOK * D, (const bf16*)(ws + WS_W1) + (size_t)fi * 2 * DFF * D, HTOK, 2 * DFF, D, E, tid); if (hh_ == 0) xcd_barrier(xbar); } PH_END
#else
                PH_BEGIN for (int rp_ = 0; rp_ < REP_FFN1; ++rp_) { pg8::EpiSwiglu E{AR, DFF, prep_rstd<false>(lds, SSQ, NTOK, 2 * DFF, tid)}; run_gemm(lds, XB, (const bf16*)(ws + WS_W1) + (size_t)fi * 2 * DFF * D, NTOK, 2 * DFF, D, E, tid); } PH_END
#endif
                PH_BEGIN for (int rp_ = 0; rp_ < REP_FFN2; ++rp_) { pg8::EpiResid E{XB, (rp_ == REP_FFN2 - 1) ? 0.5f : 0.0f, SSQ}; run_gemm(lds, AR, (const bf16*)(ws + WS_W2) + (size_t)fi * D * DFF, NTOK, D, DFF, E, tid); } PH_END
            } else {
                const int kind = li % 3;
                if (kind == 0) {
                    const int ia = li / 3;
                    for (int half = 0; half < 2; ++half) {
                        PH_BEGIN for (int rp_ = 0; rp_ < REP_HG; ++rp_) { pg8::EpiHg E{AR, (const float*)(ws + WS_LB) + li * 2048, prep_rstd<false>(lds, SSQ + (size_t)half * HTOK * 16, HTOK, 5 * D, tid)}; run_gemm(lds, XB + (size_t)half * HTOK * D, (const bf16*)(ws + WS_HGIN) + (size_t)ia * 5 * D * D, HTOK, 5 * D, D, E, tid); } PH_END
                        PH_BEGIN for (int rp_ = 0; rp_ < REP_SCAN; ++rp_) { if (half == 0) scan_phase<64>(AR, OF, OB, 0, lds, tid); else scan_phase<128>(AR, OF, OB, 1, lds, tid); } PH_END
                        PH_BEGIN for (int rp_ = 0; rp_ < REP_MISC; ++rp_) combine_phase(OF, OB, AR, PTR(0) + ia * D, AO + (size_t)half * HTOK * D, tid); PH_END
                    }
                    PH_BEGIN for (int rp_ = 0; rp_ < REP_WO; ++rp_) { pg8::EpiResid E{XB, (rp_ == REP_WO - 1) ? 1.0f : 0.0f, SSQ}; run_gemm(lds, AO, (const bf16*)(ws + WS_HGO) + (size_t)ia * D * D, NTOK, D, D, E, tid); } PH_END
                } else if (kind == 1) {
                    PH_BEGIN { pg8::EpiStore<false> E{AR, 1280, prep_rstd<false>(lds, SSQ, NTOK, 1280, tid)}; run_gemm(lds, XB, (const bf16*)(ws + WS_SWQKV), NTOK, 1280, D, E, tid); }
                             { pg8::EpiStore<true> E{VT, NTOK, prep_rstd<true>(lds, SSQ, 256, NTOK, tid)}; run_gemm(lds, (const bf16*)(ws + WS_SWQKV) + (size_t)1280 * D, XB, 256, NTOK, D, E, tid); } PH_END
                    PH_BEGIN for (int rp_ = 0; rp_ < REP_ATTN; ++rp_) swa_phase(AR, VT, AO, PTR(1), (const float*)(ws + WS_ROPE), lds, tid); PH_END
                    PH_BEGIN for (int rp_ = 0; rp_ < REP_WO; ++rp_) { pg8::EpiResid E{XB, (rp_ == REP_WO - 1) ? 1.0f : 0.0f, SSQ}; run_gemm(lds, AO, (const bf16*)(ws + WS_SWO), NTOK, D, D, E, tid); } PH_END
                } else {
                    PH_BEGIN { pg8::EpiStore<false> E{AR, 2048, prep_rstd<false>(lds, SSQ, NTOK, 2048, tid)}; run_gemm(lds, XB, (const bf16*)(ws + WS_NAQKV), NTOK, 2048, D, E, tid); }
                             { pg8::EpiStore<true> E{VT, NTOK, prep_rstd<true>(lds, SSQ, D, NTOK, tid)}; run_gemm(lds, (const bf16*)(ws + WS_NAQKV) + (size_t)2048 * D, XB, D, NTOK, D, E, tid); } PH_END
                    PH_BEGIN for (int rp_ = 0; rp_ < REP_ATTN; ++rp_) na_phase(AR, VT, AO, PTR(2), lds, tid); PH_END
                    PH_BEGIN for (int rp_ = 0; rp_ < REP_WO; ++rp_) { pg8::EpiResid E{XB, (rp_ == REP_WO - 1) ? 1.0f : 0.0f, SSQ}; run_gemm(lds, AO, (const bf16*)(ws + WS_NAO), NTOK, D, D, E, tid); } PH_END
                }
            }
        }
    }
    PH_BEGIN for (int rp_ = 0; rp_ < REP_MISC; ++rp_) final_phase(XB, SSQ, PTR(3), (float*)AO, tid); PH_END
}
constexpr int NPHASES = 1 + 4 * 4 + (7 + 3 + 3 + 7) + 1;

#ifndef MULTI_LAUNCH
#define MULTI_LAUNCH 0
#endif
extern "C" void kernel_launch(void* const* d_in, const int* in_sizes, int n_in, void* d_out, int out_size, void* d_ws, size_t ws_size, hipStream_t stream) {
    static int grid = 0;
    if (grid == 0) {
        if (n_in != 16 || out_size != NTOK * D || ws_size < WS_NEED) { fprintf(stderr, "kernel_launch: unexpected shapes (n_in %d out %d ws %zu)\n", n_in, out_size, ws_size); grid = -1; return; }
        int dev = 0, cus = 0, per_cu = 0;
        hipGetDevice(&dev); hipDeviceGetAttribute(&cus, hipDeviceAttributeMultiprocessorCount, dev);
        if (hipFuncSetAttribute((const void*)fwd, hipFuncAttributeMaxDynamicSharedMemorySize, LDS_BYTES) != hipSuccess) { fprintf(stderr, "kernel_launch: hipFuncSetAttribute failed\n"); grid = -1; return; }
        if (hipOccupancyMaxActiveBlocksPerMultiprocessor(&per_cu, (const void*)fwd, 512, LDS_BYTES) != hipSuccess || per_cu < 1) { fprintf(stderr, "kernel_launch: occupancy query says %d\n", per_cu); per_cu = 1; }
        (void)hipGetLastError();
        grid = cus * per_cu;
    }
    if (grid < 0) return;
    Args a; memset(&a, 0, sizeof(a));
    const float** ip = (const float**)&a.in;
    for (int i = 0; i < 16; ++i) ip[i] = (const float*)d_in[i];
    a.out = (float*)d_out; a.ws = (unsigned char*)d_ws;
    for (int j = 0; j < 8; ++j) a.inv[j] = exp(-(double)j * (2.0 / 16.0) * log(500000.0));
#if MULTI_LAUNCH
    for (int p = 0; p < NPHASES; ++p) { a.lo = p; a.hi = p + 1; hipLaunchKernelGGL(fwd, dim3(grid), dim3(512), LDS_BYTES, stream, a); }
#else
    a.lo = 0; a.hi = NPHASES;
    (void)hipMemsetAsync((unsigned char*)d_ws + WS_BAR, 0, 16384, stream);
    void* args[] = {&a};
    hipError_t e = hipLaunchCooperativeKernel((const void*)fwd, dim3(grid), dim3(512), args, LDS_BYTES, stream);
    if (e != hipSuccess) fprintf(stderr, "cooperative launch failed: %s (grid %d)\n", hipGetErrorString(e), grid);
#endif
}
```

```cpp
#include <hip/hip_runtime.h>
#include <hip/hip_cooperative_groups.h>
#include <cstdio>
#include <cstdint>
#include <cstring>
#include <cmath>
namespace cg = cooperative_groups;
#ifndef GEMM_WGM
#define GEMM_WGM 8
#endif
namespace pg8 {
#define PG8_LAS __attribute__((address_space(3)))
typedef unsigned short bf16_t;
typedef short bf16x8 __attribute__((ext_vector_type(8)));
typedef float f32x4 __attribute__((ext_vector_type(4)));
typedef unsigned u32x4 __attribute__((ext_vector_type(4)));
constexpr int BM = 256, BK = 64, HALF = 128, HTB = HALF * BK * 2  , STAGE_BYTES = 8 * HTB, NXCD = 8, WGM = GEMM_WGM;

__host__ __device__ __forceinline__ int lds_byte(int r, int c) { const int st = (r >> 4) * 2 + (c >> 5), rr = r & 15, cc = c & 31, ob = rr * 64 + cc * 2; return st * 1024 + (ob ^ (((ob >> 9) & 1) << 5)); }
__host__ __device__ __forceinline__ void stage_rc(int b, int& R, int& C) { const int st = b / 1024, sb = b % 1024, swz = sb ^ (((sb >> 9) & 1) << 5); R = (st >> 1) * 16 + swz / 64; C = (st & 1) * 32 + (swz % 64) / 2; }
__host__ __device__ __forceinline__ int perm32(int rho) { const int n = rho >> 4, i = rho & 15; return 8 * (i >> 2) + 4 * n + (i & 3); }

struct Unit { int pm, pn, ord; };
struct Gemm { const bf16_t* A; const bf16_t* Bt; int M, N, K; };

struct StaticOrder {
    int nM, nN, nwg, G, c;
    __host__ __device__ void init(int M, int N, int G_, int c_) { nM = M / BM; nN = N / BM; nwg = nM * nN; G = G_; c = c_; }
    __host__ __device__ bool next(int i, Unit& u) const {
        const long L = (long)i * G + c; if (L >= nwg) return false; u.ord = i;
        int wgid = (int)L; { const int q = nwg / NXCD, r = nwg % NXCD, xcd = wgid % NXCD, off = wgid / NXCD; wgid = (xcd < r ? xcd * (q + 1) : r * (q + 1) + (xcd - r) * q) + off; }
        const int nig = WGM * nN, gid = wgid / nig, fm = gid * WGM, gsz = (nM - fm) < WGM ? (nM - fm) : WGM;
        u.pm = fm + ((wgid % nig) % gsz); u.pn = (wgid % nig) / gsz; return true;
    }
    __device__ __forceinline__ void a_ready(const Unit&) const {}
    __device__ __forceinline__ void done(const Unit&) const {}
};

typedef float f32x2c __attribute__((ext_vector_type(2))); typedef __bf16 bf16x2c __attribute__((ext_vector_type(2)));
__device__ __forceinline__ unsigned cvt_pk_bf16(float lo, float hi) { const f32x2c v = {lo, hi}; const bf16x2c b = __builtin_convertvector(v, bf16x2c); return __builtin_bit_cast(unsigned, b); }
typedef float f32x2 __attribute__((ext_vector_type(2)));
__device__ __forceinline__ float fast_sigmoid(float x) { return __builtin_amdgcn_rcpf(1.0f + __expf(-x)); }
__device__ __forceinline__ float rstd_row(const float* part, int row) { const f32x4* p = (const f32x4*)(part + (size_t)row * 16); const f32x4 a = p[0], b = p[1], c = p[2], d = p[3];
    const float ss = ((a[0] + a[1]) + (a[2] + a[3])) + ((b[0] + b[1]) + (b[2] + b[3])) + ((c[0] + c[1]) + (c[2] + c[3])) + ((d[0] + d[1]) + (d[2] + d[3]));
    return __builtin_amdgcn_rsqf(ss * (1.0f / 1024.0f) + 1e-6f); }
struct EpiSwiglu {
    static constexpr bool PERM = true, AFTER_DRAIN = false;
    bf16_t* H; int ldh; const float* rtab;
    __device__ __forceinline__ void operator()(const f32x4 (&acc)[2][2][4][2], const Unit& u, int wr, int wc, int fr, int fq) const {
        const int row0 = u.pm * BM + wr * 64 + fr, col0 = u.pn * HALF + wc * 32 + 8 * fq;
#pragma unroll
        for (int ai = 0; ai < 2; ++ai)
#pragma unroll
            for (int m = 0; m < 4; ++m) {
                const int row = row0 + ai * HALF + m * 16;
                bf16_t* rowp = H + (size_t)row * ldh + col0;
                const float rs = rtab[u.ord * 256 + wr * 64 + fr + ai * HALF + m * 16];
                const float nrl = rs * -1.4426950408889634f, rs2 = rs * rs;
                unsigned w[4];
#pragma unroll
                for (int n = 0; n < 2; ++n)
#pragma unroll
                    for (int p = 0; p < 2; ++p) {
                        const f32x2 g = {acc[ai][0][m][n][2 * p], acc[ai][0][m][n][2 * p + 1]}, up = {acc[ai][1][m][n][2 * p], acc[ai][1][m][n][2 * p + 1]};
                        const f32x2 a = g * nrl; f32x2 d; d.x = __builtin_amdgcn_exp2f(a.x); d.y = __builtin_amdgcn_exp2f(a.y);
                        d = d + 1.0f; f32x2 r; r.x = __builtin_amdgcn_rcpf(d.x); r.y = __builtin_amdgcn_rcpf(d.y);
                        const f32x2 h = ((g * up) * rs2) * r;
                        w[2 * n + p] = cvt_pk_bf16(h.x, h.y); }
                u32x4 wv = {w[0], w[1], w[2], w[3]};
                __builtin_nontemporal_store(wv, (u32x4*)rowp);
            }
    }
};
struct EpiResid {
    static constexpr bool PERM = true, AFTER_DRAIN = false;
    bf16_t* XB; float scale; float* ssq;
    __device__ __forceinline__ void operator()(const f32x4 (&acc)[2][2][4][2], const Unit& u, int wr, int wc, int fr, int fq) const {
        const int row0 = u.pm * BM + wr * 64 + fr, col0 = u.pn * BM + wc * 32 + 8 * fq;
        bf16_t* xb = XB + (size_t)row0 * 1024 + col0;
        u32x4 xo[8][2];
#pragma unroll
        for (int g = 0; g < 8; ++g) { const bf16_t* p_ = xb + (size_t)((g >> 2) * HALF + (g & 3) * 16) * 1024; xo[g][0] = *(const u32x4*)(p_); xo[g][1] = *(const u32x4*)(p_ + HALF); }
#pragma unroll
        for (int g = 0; g < 8; ++g) {
            const int ai = g >> 2, m = g & 3;
            const int row = row0 + ai * HALF + m * 16;
            bf16_t* rowp = XB + (size_t)row * 1024 + col0;
            float part = 0.f;
#pragma unroll
            for (int bj = 0; bj < 2; ++bj) {
                const unsigned w[4] = {xo[g][bj][0], xo[g][bj][1], xo[g][bj][2], xo[g][bj][3]};
                float t[8];
#pragma unroll
                for (int i = 0; i < 4; ++i) { t[2 * i] = __uint_as_float(w[i] << 16) + acc[ai][bj][m][i >> 1][(2 * i) & 3] * scale; t[2 * i + 1] = __uint_as_float(w[i] & 0xffff0000u) + acc[ai][bj][m][i >> 1][(2 * i + 1) & 3] * scale; }
#pragma unroll
                for (int i = 0; i < 8; ++i) part += t[i] * t[i];
                u32x4 o; o.x = cvt_pk_bf16(t[0], t[1]); o.y = cvt_pk_bf16(t[2], t[3]); o.z = cvt_pk_bf16(t[4], t[5]); o.w = cvt_pk_bf16(t[6], t[7]);
                *(u32x4*)(rowp + bj * HALF) = o;
            }
            part += __shfl_xor(part, 16); part += __shfl_xor(part, 32);
            if (fq == 0) ssq[(size_t)row * 16 + u.pn * 4 + wc] = part;
        }
    }
};
template <bool COLS> struct EpiStore {
    static constexpr bool PERM = true, AFTER_DRAIN = false;
    bf16_t* O; size_t ldo; const float* rtab;
    __device__ __forceinline__ void operator()(const f32x4 (&acc)[2][2][4][2], const Unit& u, int wr, int wc, int fr, int fq) const {
        const int row0 = u.pm * BM + wr * 64 + fr, col0 = u.pn * BM + wc * 32 + 8 * fq;
        f32x4 cs[2][2];
        if (COLS) {
#pragma unroll
            for (int bj = 0; bj < 2; ++bj)
#pragma unroll
                for (int n = 0; n < 2; ++n) cs[bj][n] = *(const f32x4*)(rtab + u.ord * 256 + wc * 32 + 8 * fq + bj * HALF + 4 * n);
        }
#pragma unroll
        for (int ai = 0; ai < 2; ++ai)
#pragma unroll
            for (int m = 0; m < 4; ++m) {
                const int row = row0 + ai * HALF + m * 16;
                bf16_t* rowp = O + (size_t)row * ldo + col0;
                const float rs = COLS ? 1.0f : rtab[u.ord * 256 + wr * 64 + fr + ai * HALF + m * 16];
#pragma unroll
                for (int bj = 0; bj < 2; ++bj) { const f32x4 v0 = COLS ? acc[ai][bj][m][0] * cs[bj][0] : acc[ai][bj][m][0] * rs, v1 = COLS ? acc[ai][bj][m][1] * cs[bj][1] : acc[ai][bj][m][1] * rs;
                    u32x4 w; w.x = cvt_pk_bf16(v0[0], v0[1]); w.y = cvt_pk_bf16(v0[2], v0[3]); w.z = cvt_pk_bf16(v1[0], v1[1]); w.w = cvt_pk_bf16(v1[2], v1[3]);
                    *(u32x4*)(rowp + bj * HALF) = w; }
            }
    }
};
__device__ __forceinline__ unsigned pk_f16(float a, float b) { const _Float16 ha = (_Float16)a, hb = (_Float16)b; return (unsigned)__builtin_bit_cast(unsigned short, ha) | ((unsigned)__builtin_bit_cast(unsigned short, hb) << 16); }
struct EpiHg {
    static constexpr bool PERM = true, AFTER_DRAIN = false;
    bf16_t* O; const float* lb; const float* rtab;
    __device__ __forceinline__ void operator()(const f32x4 (&acc)[2][2][4][2], const Unit& u, int wr, int wc, int fr, int fq) const {
        const int row0 = u.pm * BM + wr * 64 + fr, col0 = u.pn * BM + wc * 32 + 8 * fq;
        const bool gate = (u.pn >= 12);
        f32x4 lbv[2][2];
#pragma unroll
        for (int bj = 0; bj < 2; ++bj)
#pragma unroll
            for (int n = 0; n < 2; ++n) lbv[bj][n] = gate ? *(const f32x4*)(lb + (col0 - 3072) + bj * HALF + 4 * n) : (f32x4){0.f, 0.f, 0.f, 0.f};
#pragma unroll
        for (int ai = 0; ai < 2; ++ai)
#pragma unroll
            for (int m = 0; m < 4; ++m) {
                const int row = row0 + ai * HALF + m * 16;
                bf16_t* rowp = O + (size_t)row * 5120 + col0;
                const float rs = rtab[u.ord * 256 + wr * 64 + fr + ai * HALF + m * 16];
#pragma unroll
                for (int bj = 0; bj < 2; ++bj) { const f32x4 v0 = acc[ai][bj][m][0] * rs, v1 = acc[ai][bj][m][1] * rs;
                    u32x4 w;
                    if (gate) {
                        float o[8];
#pragma unroll
                        for (int e = 0; e < 4; ++e) { const float l0 = lbv[bj][0][e], l1 = lbv[bj][1][e];
                            o[e] = __log2f(l0 + (1.0f - l0) * fast_sigmoid(v0[e])); o[4 + e] = __log2f(l1 + (1.0f - l1) * fast_sigmoid(v1[e])); }
                        w.x = pk_f16(o[0], o[1]); w.y = pk_f16(o[2], o[3]); w.z = pk_f16(o[4], o[5]); w.w = pk_f16(o[6], o[7]);
                    } else { w.x = cvt_pk_bf16(v0[0], v0[1]); w.y = cvt_pk_bf16(v0[2], v0[3]); w.z = cvt_pk_bf16(v1[0], v1[1]); w.w = cvt_pk_bf16(v1[2], v1[3]); }
                    __builtin_nontemporal_store(w, (u32x4*)(rowp + bj * HALF)); }
            }
    }
};
template <class Epi, class Sched, bool ALIGN_EPI = false, bool SP2 = false>
__device__ __forceinline__ void gemm_phase(PG8_LAS unsigned char* lds, const Gemm g, const Sched& S, const Epi& E, const int tid) {
    const int wid = __builtin_amdgcn_readfirstlane(tid >> 6), lane = tid & 63, wr = wid >> 2, wc = wid & 3, fr = lane & 15, fq = lane >> 4;
    const int K = g.K, nt = K / BK;
    unsigned voffA[2], voffB[2];
#pragma unroll
    for (int i = 0; i < 2; ++i) { int R, C; stage_rc(tid * 16 + i * 8192, R, C); const int Rb = Epi::PERM ? ((R & ~31) + perm32(R & 31)) : R;
        voffA[i] = (unsigned)(R * K + C) * 2u; voffB[i] = (unsigned)(Rb * K + C) * 2u; }
    const size_t kstep = (size_t)(BK * 2);
    const size_t hstep = (size_t)HALF * K * 2;
    const size_t tstep = 2 * hstep;
    const unsigned ldsw = (unsigned)wid * 1024u;
    const int aoff = lds_byte(wr * 64 + fr, fq * 8), boff = lds_byte(wc * 32 + fr, fq * 8);
#define PG8_SA(b, h) (((b) * 2 + (h)) * HTB)
#define PG8_SB(b, h) ((4 + (b) * 2 + (h)) * HTB)
#define PG8_STAGE(bufoff, gbase, voff) do { _Pragma("unroll") for (int _i = 0; _i < 2; ++_i) \
        __builtin_amdgcn_global_load_lds((const unsigned*)((const char*)(gbase) + (voff)[_i]), (PG8_LAS unsigned*)(lds + (bufoff) + ldsw + _i * 8192), 16, 0, 0); } while (0)
#define PG8_LDA(dst, b, h) do { _Pragma("unroll") for (int m = 0; m < 4; ++m) _Pragma("unroll") for (int k = 0; k < 2; ++k) dst[m][k] = *(const PG8_LAS bf16x8*)(lds + PG8_SA(b, h) + aoff + m * 2048 + k * 1024); } while (0)
#define PG8_LDB(dst, b, h) do { _Pragma("unroll") for (int n = 0; n < 2; ++n) _Pragma("unroll") for (int k = 0; k < 2; ++k) dst[n][k] = *(const PG8_LAS bf16x8*)(lds + PG8_SB(b, h) + boff + n * 2048 + k * 1024); } while (0)
#define PG8_MMA(ai, bj, At, Bt) do { __builtin_amdgcn_s_setprio(1); _Pragma("unroll") for (int m = 0; m < 4; ++m) _Pragma("unroll") for (int n = 0; n < 2; ++n) _Pragma("unroll") for (int k = 0; k < 2; ++k) \
        acc[ai][bj][m][n] = __builtin_amdgcn_mfma_f32_16x16x32_bf16(Bt[n][k], At[m][k], acc[ai][bj][m][n], 0, 0, 0); __builtin_amdgcn_s_setprio(0); } while (0)
#define PG8_WAIT_V(n) asm volatile("s_waitcnt vmcnt(" #n ")" ::: "memory")
#define PG8_WAIT_L(n) asm volatile("s_waitcnt lgkmcnt(" #n ")" ::: "memory")
#define PG8_BAR __builtin_amdgcn_s_barrier()
#define PG8_SCHED __builtin_amdgcn_sched_barrier(0)
    Unit cur, nxt; int ui = 0;
    if (!S.next(0, cur)) return;
    f32x4 acc[2][2][4][2];
#pragma unroll
    for (int a = 0; a < 2; ++a)
#pragma unroll
        for (int b = 0; b < 2; ++b)
#pragma unroll
            for (int m = 0; m < 4; ++m)
#pragma unroll
                for (int n = 0; n < 2; ++n) acc[a][b][m][n] = (f32x4){0.f, 0.f, 0.f, 0.f};
    bf16x8 At[4][2], B0[2][2], B1[2][2];
    const char* cA = (const char*)g.A + (size_t)cur.pm * tstep; const char* cB = (const char*)g.Bt + (size_t)cur.pn * tstep;
    S.a_ready(cur);
    if constexpr (SP2) {
        PG8_STAGE(PG8_SB(0, 0), cB, voffB); PG8_STAGE(PG8_SB(0, 1), cB + hstep, voffB); PG8_STAGE(PG8_SA(0, 0), cA, voffA); PG8_STAGE(PG8_SA(0, 1), cA + hstep, voffA);
        if (wr == 1) PG8_BAR;
        PG8_WAIT_V(2); PG8_BAR;
        PG8_STAGE(PG8_SB(1, 0), cB + kstep, voffB); PG8_STAGE(PG8_SA(1, 0), cA + kstep, voffA); PG8_STAGE(PG8_SB(1, 1), cB + hstep + kstep, voffB);
        PG8_WAIT_V(6); PG8_BAR;
    } else {
        PG8_STAGE(PG8_SB(0, 0), cB, voffB); PG8_STAGE(PG8_SA(0, 0), cA, voffA); PG8_STAGE(PG8_SB(0, 1), cB + hstep, voffB); PG8_STAGE(PG8_SA(0, 1), cA + hstep, voffA);
        if (wr == 1) PG8_BAR;
        PG8_WAIT_V(4); PG8_BAR;
        PG8_STAGE(PG8_SB(1, 0), cB + kstep, voffB); PG8_STAGE(PG8_SA(1, 0), cA + kstep, voffA); PG8_STAGE(PG8_SB(1, 1), cB + hstep + kstep, voffB);
        PG8_WAIT_V(6); PG8_BAR;
    }
    for (;;) {
        const bool has_next = S.next(ui + 1, nxt);
        const char* nA = has_next ? (const char*)g.A + (size_t)nxt.pm * tstep : cA; const char* nB = has_next ? (const char*)g.Bt + (size_t)nxt.pn * tstep : cB;
        for (int t = 0; t < nt; t += 2) {
            const bool last = (t == nt - 2);
            const char* a1 = cA + (size_t)(t + 1) * kstep;
            const char* a2 = last ? nA : cA + (size_t)(t + 2) * kstep; const char* b2 = last ? nB : cB + (size_t)(t + 2) * kstep;
            const char* a3 = a2 + kstep; const char* b3 = b2 + kstep;
            if (last && has_next) S.a_ready(nxt);
            if constexpr (SP2) {
            PG8_LDB(B0, 0, 0); PG8_LDB(B1, 0, 1); PG8_SCHED; PG8_LDA(At, 0, 0); PG8_STAGE(PG8_SA(1, 1), a1 + hstep, voffA);
            PG8_WAIT_V(8); PG8_WAIT_L(0); PG8_BAR; PG8_MMA(0, 0, At, B0); PG8_MMA(0, 1, At, B1); PG8_BAR; PG8_SCHED;
            PG8_LDA(At, 0, 1); PG8_STAGE(PG8_SB(0, 0), b2, voffB); PG8_STAGE(PG8_SB(0, 1), b2 + hstep, voffB); PG8_STAGE(PG8_SA(0, 0), a2, voffA);
            PG8_WAIT_V(8); PG8_WAIT_L(0); PG8_BAR; PG8_MMA(1, 0, At, B0); PG8_MMA(1, 1, At, B1); PG8_BAR; PG8_SCHED;
            PG8_LDB(B0, 1, 0); PG8_LDB(B1, 1, 1); PG8_SCHED; PG8_LDA(At, 1, 0); PG8_STAGE(PG8_SA(0, 1), a2 + hstep, voffA);
            PG8_WAIT_V(8); PG8_WAIT_L(0); PG8_BAR; PG8_MMA(0, 0, At, B0); PG8_MMA(0, 1, At, B1); PG8_BAR; PG8_SCHED;
            PG8_LDA(At, 1, 1); PG8_STAGE(PG8_SB(1, 0), b3, voffB); PG8_STAGE(PG8_SB(1, 1), b3 + hstep, voffB); PG8_STAGE(PG8_SA(1, 0), a3, voffA);
            PG8_WAIT_V(8); PG8_WAIT_L(0); PG8_BAR; PG8_MMA(1, 0, At, B0); PG8_MMA(1, 1, At, B1); PG8_BAR; PG8_SCHED;
            } else {
            PG8_LDB(B0, 0, 0); PG8_SCHED; PG8_LDA(At, 0, 0); PG8_STAGE(PG8_SA(1, 1), a1 + hstep, voffA);
            PG8_WAIT_L(8); PG8_BAR; PG8_WAIT_L(0); PG8_MMA(0, 0, At, B0); PG8_BAR; PG8_SCHED;
            PG8_LDB(B1, 0, 1); PG8_STAGE(PG8_SB(0, 0), b2, voffB);
            PG8_BAR; PG8_WAIT_L(0); PG8_MMA(0, 1, At, B1); PG8_BAR;
            PG8_LDA(At, 0, 1); PG8_STAGE(PG8_SA(0, 0), a2, voffA);
            PG8_BAR; PG8_WAIT_L(0); PG8_MMA(1, 0, At, B0); PG8_BAR; PG8_SCHED;
            PG8_STAGE(PG8_SB(0, 1), b2 + hstep, voffB);
            PG8_WAIT_V(6); PG8_BAR; PG8_MMA(1, 1, At, B1); PG8_BAR;
            PG8_LDB(B0, 1, 0); PG8_SCHED; PG8_LDA(At, 1, 0); PG8_STAGE(PG8_SA(0, 1), a2 + hstep, voffA);
            PG8_WAIT_L(8); PG8_BAR; PG8_WAIT_L(0); PG8_MMA(0, 0, At, B0); PG8_BAR; PG8_SCHED;
            PG8_LDB(B1, 1, 1); PG8_STAGE(PG8_SB(1, 0), b3, voffB);
            PG8_BAR; PG8_WAIT_L(0); PG8_MMA(0, 1, At, B1); PG8_BAR;
            PG8_LDA(At, 1, 1); PG8_STAGE(PG8_SA(1, 0), a3, voffA);
            PG8_BAR; PG8_WAIT_L(0); PG8_MMA(1, 0, At, B0); PG8_BAR; PG8_SCHED;
            PG8_STAGE(PG8_SB(1, 1), b3 + hstep, voffB);
            PG8_WAIT_V(6); PG8_BAR; PG8_MMA(1, 1, At, B1); PG8_BAR;
            }
        }
        if constexpr (ALIGN_EPI) { if (wr == 0) PG8_BAR; }
        if constexpr (!Epi::AFTER_DRAIN) { E(acc, cur, wr, wc, fr, fq); S.done(cur); }
        if (!has_next) break;
#pragma unroll
        for (int a = 0; a < 2; ++a)
#pragma unroll
            for (int b = 0; b < 2; ++b)
#pragma unroll
                for (int m = 0; m < 4; ++m)
#pragma unroll
                    for (int n = 0; n < 2; ++n) acc[a][b][m][n] = (f32x4){0.f, 0.f, 0.f, 0.f};
        cur = nxt; cA = nA; cB = nB; ++ui;
        if constexpr (ALIGN_EPI) { if (wr == 1) PG8_BAR; }
    }
    PG8_WAIT_V(0);
    if constexpr (!ALIGN_EPI) { if (wr == 0) PG8_BAR; }
    PG8_BAR;
    if constexpr (Epi::AFTER_DRAIN) { E.fused(acc, cur, wr, wc, fr, fq, lds, wid, lane); S.done(cur); }
#undef PG8_SA
#undef PG8_SB
#undef PG8_STAGE
#undef PG8_LDA
#undef PG8_LDB
#undef PG8_MMA
#undef PG8_WAIT_V
#undef PG8_WAIT_L
#undef PG8_BAR
#undef PG8_SCHED
}
}
#ifndef GEMM_ALIGN
#define GEMM_ALIGN true
#endif
#ifndef GEMM_SP2
#define GEMM_SP2 true
#endif
typedef unsigned short bf16;
typedef float f32x4 __attribute__((ext_vector_type(4)));
typedef float f32x16 __attribute__((ext_vector_type(16)));
typedef short bf16x8 __attribute__((ext_vector_type(8)));
typedef unsigned u32x4 __attribute__((ext_vector_type(4)));
typedef unsigned u32x2 __attribute__((ext_vector_type(2)));
#define LAS __attribute__((address_space(3)))
#define DI __device__ __forceinline__

constexpr int D = 1024, NTOK = 65536, HTOK = 32768, DFF = 2816, NW = 8;
constexpr float EPS = 1e-6f, LOG2E = 1.4426950408889634f;
constexpr size_t MiB = (size_t)1 << 20;
constexpr size_t WS_LB = 0;
constexpr size_t WS_ROPE = 64 * 1024;
constexpr size_t WS_PTR = 512 * 1024;
constexpr size_t WS_BAR = 1 * MiB;
constexpr size_t WS_W1 = 2 * MiB;
constexpr size_t WS_W2 = 90 * MiB;
constexpr size_t WS_HGIN = 134 * MiB;
constexpr size_t WS_HGO = 154 * MiB;
constexpr size_t WS_SWQKV = 158 * MiB;
constexpr size_t WS_SWO = 161 * MiB;
constexpr size_t WS_NAQKV = 163 * MiB;
constexpr size_t WS_NAO = 169 * MiB;
constexpr size_t WS_SSQ = 172 * MiB;
constexpr size_t WS_XN = 176 * MiB;
constexpr size_t WS_AR = 304 * MiB;
constexpr size_t AR_VT = 256 * MiB, AR_OB = 320 * MiB;
constexpr size_t WS_NEED = 704 * MiB;
constexpr int LDS_BYTES = 131072 + 24576;

typedef float f32x2_t __attribute__((ext_vector_type(2))); typedef __bf16 bf16x2_t __attribute__((ext_vector_type(2)));
DI unsigned cvtpk(float lo, float hi) { const f32x2_t v = {lo, hi}; const bf16x2_t b = __builtin_convertvector(v, bf16x2_t); return __builtin_bit_cast(unsigned, b); }
DI float bf2f(unsigned short b) { return __uint_as_float((unsigned)b << 16); }
DI float bflo(unsigned w) { return __uint_as_float(w << 16); }
DI float bfhi(unsigned w) { return __uint_as_float(w & 0xffff0000u); }
DI unsigned short f2bf(float f) { return (unsigned short)(cvtpk(f, 0.f) & 0xffffu); }
DI float h2f(unsigned short h) { return (float)__builtin_bit_cast(_Float16, h); }
DI float wave_sum(float v) {
#pragma unroll
    for (int o = 1; o < 64; o <<= 1) v += __shfl_xor(v, o);
    return v;
}
DI int imin(int a, int b) { return a < b ? a : b; }
DI int imax(int a, int b) { return a > b ? a : b; }
DI int iclamp(int v, int lo, int hi) { return imin(imax(v, lo), hi); }

DI void transpose_item(const float* W, int K, int N, bf16* WT, int item, int lane, bool swiglu, const float* gk) {
    const int nblk = N / 64, kb = item / nblk, nb = item % nblk, k0 = 64 * kb, n0 = 64 * nb;
    int r0 = n0;
    if (swiglu) { r0 = (n0 < DFF) ? (n0 / 128) * 256 + (n0 % 128) : ((n0 - DFF) / 128) * 256 + 128 + ((n0 - DFF) % 128); }
    const float* src = W + (size_t)k0 * N + n0 + lane;
    bf16* dst = WT + (size_t)(r0 + lane) * K + k0;
    float v[64];
#pragma unroll
    for (int j = 0; j < 64; ++j) v[j] = __builtin_nontemporal_load(src + (size_t)j * N);
    if (gk) {
#pragma unroll
        for (int j = 0; j < 64; ++j) v[j] *= gk[k0 + j];
    }
#pragma unroll
    for (int c = 0; c < 8; ++c) { u32x4 o; o.x = cvtpk(v[8 * c], v[8 * c + 1]); o.y = cvtpk(v[8 * c + 2], v[8 * c + 3]); o.z = cvtpk(v[8 * c + 4], v[8 * c + 5]); o.w = cvtpk(v[8 * c + 6], v[8 * c + 7]);
        *(u32x4*)(dst + 8 * c) = o; }
}
struct In { const float *xp, *xs, *norm_g, *fin_g, *w1, *w2, *hg_in, *hg_o, *hg_gn, *hg_lb, *sw_qkv, *sw_o, *sw_sink, *na_qkv, *na_o, *na_rpb; };
struct Args { In in; float* out; unsigned char* ws; double inv[8]; int lo, hi; };

DI void conv_phase(const In& I, unsigned char* ws, const double* inv, unsigned char* lds, int tid) {
    const int lane = tid & 63, wave = tid >> 6;
    const int gw = blockIdx.x * NW + wave, ngw = gridDim.x * NW;
    constexpr int I_W1 = 16 * 88, I_W2 = 44 * 16, I_HGIN = 16 * 80, I_SQ = 16 * 16, I_SWQ = 16 * 24, I_NAQ = 16 * 48;
    constexpr int NIT = 8 * I_W1 + 8 * I_W2 + 2 * I_HGIN + 2 * I_SQ + I_SWQ + I_SQ + I_NAQ + I_SQ;
    for (int it = gw; it < NIT; it += ngw) {
        int r = it;
        if (r < 8 * I_W1) { const int m = r / I_W1; transpose_item(I.w1 + (size_t)m * D * 2 * DFF, D, 2 * DFF, (bf16*)(ws + WS_W1) + (size_t)m * 2 * DFF * D, r % I_W1, lane, true, I.norm_g + ((m >> 1) * 3 + (m & 1) * 2) * D); continue; } r -= 8 * I_W1;
        if (r < 8 * I_W2) { const int m = r / I_W2; transpose_item(I.w2 + (size_t)m * DFF * D, DFF, D, (bf16*)(ws + WS_W2) + (size_t)m * D * DFF, r % I_W2, lane, false, nullptr); continue; } r -= 8 * I_W2;
        if (r < 2 * I_HGIN) { const int m = r / I_HGIN; transpose_item(I.hg_in + (size_t)m * D * 5 * D, D, 5 * D, (bf16*)(ws + WS_HGIN) + (size_t)m * 5 * D * D, r % I_HGIN, lane, false, I.norm_g + (m * 9 + 1) * D); continue; } r -= 2 * I_HGIN;
        if (r < 2 * I_SQ) { const int m = r / I_SQ; transpose_item(I.hg_o + (size_t)m * D * D, D, D, (bf16*)(ws + WS_HGO) + (size_t)m * D * D, r % I_SQ, lane, false, nullptr); continue; } r -= 2 * I_SQ;
        if (r < I_SWQ) { transpose_item(I.sw_qkv, D, 1536, (bf16*)(ws + WS_SWQKV), r, lane, false, I.norm_g + 4 * D); continue; } r -= I_SWQ;
        if (r < I_SQ) { transpose_item(I.sw_o, D, D, (bf16*)(ws + WS_SWO), r, lane, false, nullptr); continue; } r -= I_SQ;
        if (r < I_NAQ) { transpose_item(I.na_qkv, D, 3072, (bf16*)(ws + WS_NAQKV), r, lane, false, I.norm_g + 7 * D); continue; } r -= I_NAQ;
        transpose_item(I.na_o, D, D, (bf16*)(ws + WS_NAO), r, lane, false, nullptr);
    }
    const int gt = blockIdx.x * 512 + tid, ngt = gridDim.x * 512;
    float* lbt = (float*)(ws + WS_LB);
    for (int i = gt; i < 2048; i += ngt) { const int d = i >> 10, c = i & 1023;
        float v[4], mx = -1e30f;
        for (int l = 0; l < 4; ++l) { v[l] = I.hg_lb[(d * 4 + l) * 1024 + c]; mx = fmaxf(mx, v[l]); }
        float s = 0.f; for (int l = 0; l < 4; ++l) { v[l] = __expf(v[l] - mx); s += v[l]; }
        float cum = 0.f; lbt[(0 * 2 + d) * 1024 + c] = 0.f;
        for (int l = 1; l < 4; ++l) { cum += v[l] / s; lbt[(l * 2 + d) * 1024 + c] = cum; } }
    float* rt = (float*)(ws + WS_ROPE);
    for (int i = gt; i < 4096 * 8; i += ngt) { const int pos = i >> 3, j = i & 7;
        const double ang = (double)pos * inv[j]; const double TWO_PI = 6.283185307179586476925;
        const double r = ang - TWO_PI * __builtin_rint(ang / TWO_PI), r2 = r * r;
        double ts = r, sn = r, tc = 1.0, cs = 1.0;
        for (int n = 1; n <= 13; ++n) { ts *= -r2 / (double)((2 * n) * (2 * n + 1)); sn += ts; tc *= -r2 / (double)((2 * n - 1) * (2 * n)); cs += tc; }
        rt[pos * 16 + j] = (float)cs; rt[pos * 16 + 8 + j] = (float)sn; }
}

DI void first_phase(const float* xp, const float* xs, bf16* XB, float* ssq, int tid) {
    const int lane = tid & 63, wave = tid >> 6;
    const int gw = blockIdx.x * NW + wave, ngw = gridDim.x * NW;
    for (int row = gw; row < NTOK; row += ngw) {
        const float* src = row < HTOK ? xp + (size_t)row * D : xs + (size_t)(row - HTOK) * D;
        const f32x4* xr = (const f32x4*)src + lane;
        f32x4 v[4]; float ss = 0.f;
#pragma unroll
        for (int j = 0; j < 4; ++j) { v[j] = __builtin_nontemporal_load(xr + 64 * j); ss += (v[j].x * v[j].x + v[j].y * v[j].y) + (v[j].z * v[j].z + v[j].w * v[j].w); }
        ss = wave_sum(ss);
        u32x2* o = (u32x2*)(XB + (size_t)row * D) + lane;
#pragma unroll
        for (int j = 0; j < 4; ++j) { u32x2 w; w.x = cvtpk(v[j].x, v[j].y); w.y = cvtpk(v[j].z, v[j].w); o[64 * j] = w; }
        if (lane < 16) ssq[(size_t)row * 16 + lane] = (lane == 0) ? ss : 0.f;
    }
}
DI void final_phase(const bf16* XB, const float* ssq, const float* g, float* out, int tid) {
    const int lane = tid & 63, wave = tid >> 6;
    const int gw = blockIdx.x * NW + wave, ngw = gridDim.x * NW;
    f32x4 gv[4];
#pragma unroll
    for (int j = 0; j < 4; ++j) gv[j] = ((const f32x4*)g)[64 * j + lane];
    for (int row = gw; row < NTOK; row += ngw) {
        const float rstd = pg8::rstd_row(ssq, row);
        const u32x2* xr = (const u32x2*)(XB + (size_t)row * D) + lane;
        f32x4* o = (f32x4*)(out + (size_t)row * D) + lane;
#pragma unroll
        for (int j = 0; j < 4; ++j) { const u32x2 w = xr[64 * j]; const f32x4 v = {bflo(w.x), bfhi(w.x), bflo(w.y), bfhi(w.y)}; o[64 * j] = v * rstd * gv[j]; }
    }
}

DI void seq_of(int row, int& base, int& len) { if (row < HTOK) { len = 4096; base = row & ~4095; } else { len = 2048; base = HTOK + ((row - HTOK) & ~2047); } }

DI void rope_phase(bf16* QK, const float* rt, int tid) {
    const int gt = blockIdx.x * 512 + tid, ngt = gridDim.x * 512;
    for (int i = gt; i < NTOK * 20; i += ngt) { const int row = i / 20, hd = i % 20;
        int base, len; seq_of(row, base, len); const int pos = row - base;
        u32x4* p = (u32x4*)(QK + (size_t)row * 1280 + hd * 64);
        const u32x4 a = p[0], b = p[1];
        const f32x4* t = (const f32x4*)(rt + pos * 16); const f32x4 c0 = t[0], c1 = t[1], s0 = t[2], s1 = t[3];
        const float cs[8] = {c0.x, c0.y, c0.z, c0.w, c1.x, c1.y, c1.z, c1.w}, sn[8] = {s0.x, s0.y, s0.z, s0.w, s1.x, s1.y, s1.z, s1.w};
        const unsigned aw[4] = {a.x, a.y, a.z, a.w}, bw[4] = {b.x, b.y, b.z, b.w};
        unsigned oa[4], ob[4];
#pragma unroll
        for (int w = 0; w < 4; ++w) {
            const float x1l = bflo(aw[w]), x1h = bfhi(aw[w]), x2l = bflo(bw[w]), x2h = bfhi(bw[w]);
            oa[w] = cvtpk(x1l * cs[2 * w] - x2l * sn[2 * w], x1h * cs[2 * w + 1] - x2h * sn[2 * w + 1]);
            ob[w] = cvtpk(x2l * cs[2 * w] + x1l * sn[2 * w], x2h * cs[2 * w + 1] + x1h * sn[2 * w + 1]); }
        p[0] = (u32x4){oa[0], oa[1], oa[2], oa[3]}; p[1] = (u32x4){ob[0], ob[1], ob[2], ob[3]};
    }
}

DI int crow(int r, int hi) { return (r & 3) + 8 * (r >> 2) + 4 * hi; }
#define MFMA32(a, b, c) __builtin_amdgcn_mfma_f32_32x32x16_bf16((a), (b), (c), 0, 0, 0)
struct KVFrag { bf16x8 k[4]; bf16x8 v[2][2]; };
DI int kperm(int i) { return (i & 0x13) | ((i & 4) << 1) | ((i & 8) >> 1); }
DI int kidx(int r, int hi) { return (r & 7) + 8 * hi + 16 * (r >> 3); }
DI void kv_load(KVFrag& f, const bf16* Kp  , int ldq, const bf16* Vp  , int tok0, int l32) {
    const bf16* kr = Kp + (size_t)(tok0 + kperm(l32)) * ldq;
#pragma unroll
    for (int s = 0; s < 4; ++s) f.k[s] = *(const bf16x8*)(kr + 16 * s);
#pragma unroll
    for (int dt = 0; dt < 2; ++dt)
#pragma unroll
        for (int ks = 0; ks < 2; ++ks) f.v[dt][ks] = *(const bf16x8*)(Vp + (size_t)dt * 32 * NTOK + tok0 + 16 * ks);
}
template <class F> DI void tile_math(const bf16* Kl, const bf16* Vl, int vs, const F& f, const bf16x8 (&qf)[4], float& m, float& l, f32x16& o0, f32x16& o1, int l32, int hi) {
    bf16x8 kf[4], vf[2][2];
    const bf16* kr = Kl + kperm(l32) * 72 + 8 * hi;
#pragma unroll
    for (int s = 0; s < 4; ++s) kf[s] = *(const bf16x8*)(kr + 16 * s);
#pragma unroll
    for (int dt = 0; dt < 2; ++dt)
#pragma unroll
        for (int ks = 0; ks < 2; ++ks) vf[dt][ks] = *(const bf16x8*)(Vl + (32 * dt + l32) * vs + 16 * ks + 8 * hi);
    f32x16 s = {};
#pragma unroll
    for (int st = 0; st < 4; ++st) s = MFMA32(kf[st], qf[st], s);
    float tmax = -INFINITY;
    if (f.full()) {
#pragma unroll
        for (int r = 0; r < 16; ++r) { s[r] *= (0.125f * LOG2E); tmax = fmaxf(tmax, s[r]); }
    } else {
#pragma unroll
        for (int r = 0; r < 16; ++r) { s[r] = f.score(r, s[r]); tmax = fmaxf(tmax, s[r]); }
    }
    { const auto rr = __builtin_amdgcn_permlane32_swap(__float_as_uint(tmax), __float_as_uint(tmax), false, false); tmax = fmaxf(__uint_as_float(rr[0]), __uint_as_float(rr[1])); }
    if (__ballot(tmax > m + 8.0f) != 0ull) {
        const float mn = fmaxf(m, tmax), fs = __builtin_amdgcn_exp2f(m - mn);
        l *= fs; m = mn;
#pragma unroll
        for (int r = 0; r < 16; ++r) { o0[r] *= fs; o1[r] *= fs; }
    }
    float ps = 0.f;
#pragma unroll
    for (int r = 0; r < 16; ++r) { s[r] = __builtin_amdgcn_exp2f(s[r] - m); ps += s[r]; }
    l += ps;
#pragma unroll
    for (int ks = 0; ks < 2; ++ks) {
        u32x4 pw; pw.x = cvtpk(s[8 * ks], s[8 * ks + 1]); pw.y = cvtpk(s[8 * ks + 2], s[8 * ks + 3]); pw.z = cvtpk(s[8 * ks + 4], s[8 * ks + 5]); pw.w = cvtpk(s[8 * ks + 6], s[8 * ks + 7]);
        const bf16x8 pb = __builtin_bit_cast(bf16x8, pw);
        o0 = MFMA32(vf[0][ks], pb, o0);
        o1 = MFMA32(vf[1][ks], pb, o1);
    }
}
DI void attn_store(bf16* AO, int qtok, int ocol, const f32x16& o0, const f32x16& o1, float l, int hi) {
    l += __shfl_xor(l, 32);
    const float rl = 1.0f / l;
    bf16* op = AO + (size_t)qtok * D + ocol + 4 * hi;
#pragma unroll
    for (int g = 0; g < 4; ++g) {
        u32x2 w0, w1; w0.x = cvtpk(o0[4 * g] * rl, o0[4 * g + 1] * rl); w0.y = cvtpk(o0[4 * g + 2] * rl, o0[4 * g + 3] * rl);
        w1.x = cvtpk(o1[4 * g] * rl, o1[4 * g + 1] * rl); w1.y = cvtpk(o1[4 * g + 2] * rl, o1[4 * g + 3] * rl);
        *(u32x2*)(op + 8 * g) = w0; *(u32x2*)(op + 32 + 8 * g) = w1; }
}
DI u32x4 rope8(u32x4 mine, u32x4 other, const float* cs, bool lo) {
    const f32x4 c0 = *(const f32x4*)cs, c1 = *(const f32x4*)(cs + 4), s0 = *(const f32x4*)(cs + 8), s1 = *(const f32x4*)(cs + 12);
    const float c[8] = {c0.x, c0.y, c0.z, c0.w, c1.x, c1.y, c1.z, c1.w}, s[8] = {s0.x, s0.y, s0.z, s0.w, s1.x, s1.y, s1.z, s1.w};
    const unsigned mw[4] = {mine.x, mine.y, mine.z, mine.w}, ow[4] = {other.x, other.y, other.z, other.w};
    unsigned o[4];
#pragma unroll
    for (int w = 0; w < 4; ++w) {
        const float ml = bflo(mw[w]), mh = bfhi(mw[w]), ol = bflo(ow[w]), oh = bfhi(ow[w]);
        const float sl = lo ? -s[2 * w] : s[2 * w], sh = lo ? -s[2 * w + 1] : s[2 * w + 1];
        o[w] = cvtpk(ml * c[2 * w] + ol * sl, mh * c[2 * w + 1] + oh * sh); }
    return (u32x4){o[0], o[1], o[2], o[3]};
}
DI u32x4 shfl4(u32x4 v, int mask) { return (u32x4){(unsigned)__shfl_xor((int)v.x, mask), (unsigned)__shfl_xor((int)v.y, mask), (unsigned)__shfl_xor((int)v.z, mask), (unsigned)__shfl_xor((int)v.w, mask)}; }
struct SwaF {
    int dbase; bool fullt;
    DI bool full() const { return fullt; }
    DI float score(int r, float raw) const { const int d = dbase + (r & 7) + 16 * (r >> 3); return (d <= 128 && d >= -128) ? raw * (0.125f * LOG2E) : -INFINITY; }
};
DI void swa_phase(const bf16* QK, const bf16* VT, bf16* AO, const float* sinks, const float* rt, unsigned char* lds, int tid) {
    const int lane = tid & 63, wave = tid >> 6, l32 = lane & 31, hi = lane >> 5;
    constexpr int KB = 32 * 72, VS = 40, TB = KB + 64 * VS;
    bf16* T = (bf16*)lds;
    const int qblk = wave >> 2;
    for (int u = blockIdx.x; u < (NTOK / 64) * 4; u += gridDim.x) {
        const int row0 = (u >> 2) * 64, kvh = u & 3, hq = kvh * 4 + (wave & 3);
        int sb, len; seq_of(row0, sb, len); const int q0 = row0 - sb;
        const int t0 = (q0 < 128) ? (128 - q0) / 32 : 0, t1 = imin(9, (len - 1 - (q0 - 128)) / 32);
        const int qtok = row0 + 32 * qblk + l32, qpos = q0 + 32 * qblk + l32;
        bf16x8 qf[4];
        { const bf16* qp = QK + (size_t)qtok * 1280 + hq * 64 + 8 * hi;
#pragma unroll
          for (int s = 0; s < 4; ++s) qf[s] = *(const bf16x8*)(qp + 16 * s); }
        { const u32x4 mine = __builtin_bit_cast(u32x4, qf[0]); qf[0] = __builtin_bit_cast(bf16x8, rope8(mine, shfl4(mine, 32), rt + qpos * 16, hi == 0)); }
        float m = sinks[hq] * LOG2E, l = hi ? 0.f : 1.f; f32x16 o0 = {}, o1 = {};
        const bool isk = tid < 256; const int sr = isk ? (tid >> 3) : ((tid - 256) >> 2), sp = isk ? (tid & 7) : (tid & 3);
        const bf16* gsrc = isk ? QK + (size_t)(sb + q0 - 128 + sr) * 1280 + 1024 + kvh * 64 + sp * 8 : VT + (size_t)(kvh * 64 + sr) * NTOK + (sb + q0 - 128) + sp * 8;
        const size_t gstep = isk ? (size_t)32 * 1280 : 32;
        const int ldst = isk ? sr * 72 + sp * 8 : KB + sr * VS + sp * 8;
#define SWA_ROPE(val, t_) do { if (isk) { const u32x4 oth_ = shfl4(val, 1); if (sp < 2) val = rope8(val, oth_, rt + (q0 - 128 + 32 * (t_) + sr) * 16, sp == 0); } } while (0)
        u32x4 stg = *(const u32x4*)(gsrc + (size_t)t0 * gstep);
        SWA_ROPE(stg, t0);
        *(u32x4*)(T + (t0 & 1) * TB + ldst) = stg;
        if (t0 + 1 <= t1) stg = *(const u32x4*)(gsrc + (size_t)(t0 + 1) * gstep);
        __syncthreads();
        for (int t = t0; t <= t1; ++t) {
            if (t + 1 <= t1) { SWA_ROPE(stg, t + 1); *(u32x4*)(T + ((t + 1) & 1) * TB + ldst) = stg; }
            if (t + 2 <= t1) stg = *(const u32x4*)(gsrc + (size_t)(t + 2) * gstep);
            if (t >= qblk && t <= qblk + 8) {
                SwaF f; f.dbase = (q0 - 128 + 32 * t) + 8 * hi - qpos; { const int rel = 32 * (t - qblk) - 128; f.fullt = (rel >= -96) && (rel <= 96); }
                const bf16* tb = T + (t & 1) * TB;
                tile_math(tb, tb + KB, VS, f, qf, m, l, o0, o1, l32, hi);
            }
            __syncthreads();
        }
        attn_store(AO, qtok, hq * 64, o0, o1, l, hi);
    }
#undef SWA_ROPE
}
struct NaF {
    unsigned colmask; int dcl[16]; int qrow, rsq; const float* rpb; const float* rpt; bool rowok;
    DI bool full() const { return false; }
    DI void tile(int R) { rowok = (R >= rsq) && (R < rsq + 8); rpt = rpb + iclamp(R - qrow + 7, 0, 14) * 32; }
    DI float score(int r, float raw) const { const bool ok = rowok && ((colmask >> r) & 1u); return ok ? fmaf(raw, 0.125f * LOG2E, rpt[dcl[r]]) : -INFINITY; }
};
DI void na_phase(const bf16* QK, const bf16* VT, bf16* AO, const float* rpbg, unsigned char* lds, int tid) {
    const int lane = tid & 63, wave = tid >> 6, l32 = lane & 31, hi = lane >> 5;
    constexpr int KB = 64 * 72, VS = 72, TB = KB + 64 * VS;
    float* rp = (float*)lds;
    bf16* T = (bf16*)(lds + 16 * 15 * 32 * 4);
    for (int i = tid; i < 16 * 15 * 32; i += 512) { const int c = i & 31, hr = i >> 5; rp[i] = (c < 31) ? rpbg[hr * 31 + c] * LOG2E : 0.f; }
    __syncthreads();
    const int rpw = wave >> 2, j = wave & 3;
    for (int u = blockIdx.x; u < 4096; u += gridDim.x) {
        const int g = u >> 4, h = u & 15;
        int rows, seqb, quad;
        if (g < 128) { rows = 64; seqb = (g >> 4) * 4096; quad = g & 15; } else { const int g2 = g - 128; rows = 32; seqb = HTOK + (g2 >> 3) * 2048; quad = g2 & 7; }
        const int r0 = 4 * quad, RA = iclamp(r0 - 4, 0, rows - 8), RB = iclamp(r0 - 1, 0, rows - 8) + 7;
        const int rw = r0 + 2 * rpw, wA = iclamp(rw - 4, 0, rows - 8), wB = iclamp(rw - 3, 0, rows - 8) + 7;
        const int cst = iclamp(16 * j - 8, 0, 32);
        NaF f; f.qrow = rw + (l32 >> 4); const int qcol = 16 * j + (l32 & 15); f.rsq = iclamp(f.qrow - 4, 0, rows - 8); const int csq = iclamp(qcol - 8, 0, 48); f.rpb = rp + h * 15 * 32;
        { unsigned cm = 0u;
#pragma unroll
          for (int r = 0; r < 16; ++r) { const int kc = cst + 8 * hi + (r & 7) + 16 * (r >> 3); cm |= ((kc >= csq) && (kc < csq + 16)) ? (1u << r) : 0u; f.dcl[r] = iclamp(kc - qcol + 15, 0, 30); }
          f.colmask = cm; }
        f.rowok = false; f.rpt = f.rpb;
        const int qtok = seqb + f.qrow * 64 + qcol;
        bf16x8 qf[4];
        { const bf16* qp = QK + (size_t)qtok * 2048 + h * 64 + 8 * hi;
#pragma unroll
          for (int s = 0; s < 4; ++s) qf[s] = *(const bf16x8*)(qp + 16 * s); }
        float m = -1e30f, l = 0.f; f32x16 o0 = {}, o1 = {};
        const int sr = tid >> 3, sp = tid & 7;
        const bf16* gk = QK + (size_t)(seqb + sr) * 2048 + 1024 + h * 64 + sp * 8;
        const bf16* gv = VT + (size_t)(h * 64 + sr) * NTOK + seqb + sp * 8;
        const int lk = sr * 72 + sp * 8, lv = KB + sr * VS + sp * 8;
        u32x4 sk = *(const u32x4*)(gk + (size_t)RA * 64 * 2048), sv = *(const u32x4*)(gv + RA * 64);
        *(u32x4*)(T + (RA & 1) * TB + lk) = sk; *(u32x4*)(T + (RA & 1) * TB + lv) = sv;
        if (RA + 1 <= RB) { sk = *(const u32x4*)(gk + (size_t)(RA + 1) * 64 * 2048); sv = *(const u32x4*)(gv + (RA + 1) * 64); }
        __syncthreads();
        for (int R = RA; R <= RB; ++R) {
            if (R + 1 <= RB) { *(u32x4*)(T + ((R + 1) & 1) * TB + lk) = sk; *(u32x4*)(T + ((R + 1) & 1) * TB + lv) = sv; }
            if (R + 2 <= RB) { sk = *(const u32x4*)(gk + (size_t)(R + 2) * 64 * 2048); sv = *(const u32x4*)(gv + (R + 2) * 64); }
            if (R >= wA && R <= wB) {
                f.tile(R);
                const bf16* tb = T + (R & 1) * TB;
                tile_math(tb + cst * 72, tb + KB + cst, VS, f, qf, m, l, o0, o1, l32, hi);
            }
            __syncthreads();
        }
        attn_store(AO, qtok, h * 64, o0, o1, l, hi);
    }
}

#define MFMA16(a, b, c) __builtin_amdgcn_mfma_f32_16x16x32_bf16((a), (b), (c), 0, 0, 0)
constexpr int SQ = 136, ST = 72;
constexpr int L_QR = 0, L_KR = 17408, L_VRAW = 34816, L_KRT = 52224, L_VT = 70656, L_AM = 89088, L_SPT = 98304, L_SEG = 133120, L_EMID = 137216, L_EEND = 137728;
DI float cexp2(float x) { return __builtin_amdgcn_exp2f(fminf(fmaxf(x, -100.f), 100.f)); }
template <int VS> DI void scan_phase(const bf16* P, bf16* OF, bf16* OB, int half, unsigned char* lds, int tid) {
    constexpr int NVB = VS / 16, VSTR = (VS == 64) ? ST : SQ;
    const int lane = tid & 63, wave = tid >> 6, l16 = lane & 15, rq = lane >> 4;
    const int Tlen = half ? 2048 : 4096, nseq = half ? 16 : 8, NC = Tlen / 64, nitems = nseq * 16 * (128 / VS);
    bf16* QR = (bf16*)(lds + L_QR); bf16* KR = (bf16*)(lds + L_KR); bf16* VRAW = (bf16*)(lds + L_VRAW); bf16* KRT = (bf16*)(lds + L_KRT);
    bf16* VT = (bf16*)(lds + L_VT); bf16* AM = (bf16*)(lds + L_AM); bf16* SPT = (bf16*)(lds + L_SPT);
    float* SEG = (float*)(lds + L_SEG); float* EMID = (float*)(lds + L_EMID); float* EEND = (float*)(lds + L_EEND);
    const int lr = tid >> 3, lc = tid & 7;
    for (int item = blockIdx.x; item < nitems; item += gridDim.x) {
        int vs, dir, h, seq;
        if (VS == 64) { vs = item & 1; dir = (item >> 1) & 1; h = (item >> 2) & 7; seq = item >> 5; } else { vs = 0; dir = item & 1; h = (item >> 1) & 7; seq = item >> 4; }
        const bf16* Pq = P + (size_t)seq * Tlen * 5120 + h * 128;
        const bf16* Pv = Pq + 1024 + vs * VS;
        const bf16* Pl = Pq + 3072 + dir * 1024;
        bf16* Oo = (dir ? OB : OF) + (size_t)seq * Tlen * D + h * 128 + vs * VS;
        f32x4 S[NVB];
#pragma unroll
        for (int i = 0; i < NVB; ++i) S[i] = (f32x4){0.f, 0.f, 0.f, 0.f};
        u32x4 pq0, pq1, pl0, pl1, pv, pv1;
#define SC_TOK(c, tau) (dir ? (Tlen - 1 - ((c) * 64 + (tau))) : ((c) * 64 + (tau)))
#define SC_LOAD(c) do { const size_t ro = (size_t)SC_TOK(c, lr) * 5120; \
            pq0 = *(const u32x4*)(Pq + ro + lc * 8); pq1 = *(const u32x4*)(Pq + ro + 64 + lc * 8); \
            pl0 = *(const u32x4*)(Pl + ro + lc * 8); pl1 = *(const u32x4*)(Pl + ro + 64 + lc * 8); \
            pv = *(const u32x4*)(Pv + ro + lc * 8); if (VS == 128) pv1 = *(const u32x4*)(Pv + ro + 64 + lc * 8); } while (0)
        SC_LOAD(0);
        for (int c = 0; c < NC; ++c) {
            *(u32x4*)(QR + lr * SQ + lc * 8) = pq0; *(u32x4*)(QR + lr * SQ + 64 + lc * 8) = pq1;
            *(u32x4*)(KR + lr * SQ + lc * 8) = pl0; *(u32x4*)(KR + lr * SQ + 64 + lc * 8) = pl1;
            *(u32x4*)(VRAW + lr * VSTR + lc * 8) = pv; if (VS == 128) *(u32x4*)(VRAW + lr * VSTR + 64 + lc * 8) = pv1;
            if (c + 1 < NC) SC_LOAD(c + 1);
            __syncthreads();
            const int kp = tid & 63, seg = tid >> 6;
            unsigned lw[8], qw[8]; float lf0[8], lf1[8], cs0[8], cs1[8]; float run0 = 0.f, run1 = 0.f;
#pragma unroll
            for (int i = 0; i < 8; ++i) lw[i] = *(const unsigned*)(KR + (8 * seg + i) * SQ + 2 * kp);
#pragma unroll
            for (int i = 0; i < 8; ++i) qw[i] = *(const unsigned*)(QR + (8 * seg + i) * SQ + 2 * kp);
#pragma unroll
            for (int i = 0; i < 8; ++i) { lf0[i] = h2f((unsigned short)(lw[i] & 0xffffu)); lf1[i] = h2f((unsigned short)(lw[i] >> 16)); run0 += lf0[i]; run1 += lf1[i]; cs0[i] = run0; cs1[i] = run1; }
            *(f32x2_t*)(SEG + (seg * 64 + kp) * 2) = (f32x2_t){run0, run1};
            { constexpr int NR = VS / 8;
              const int v = tid & (VS - 1), ss = tid / VS; unsigned short t[NR];
#pragma unroll
              for (int i = 0; i < NR; ++i) t[i] = VRAW[(NR * ss + i) * VSTR + v];
#pragma unroll
              for (int j = 0; j < NR / 8; ++j) { u32x4 w; w.x = t[8 * j] | ((unsigned)t[8 * j + 1] << 16); w.y = t[8 * j + 2] | ((unsigned)t[8 * j + 3] << 16); w.z = t[8 * j + 4] | ((unsigned)t[8 * j + 5] << 16); w.w = t[8 * j + 6] | ((unsigned)t[8 * j + 7] << 16);
                  *(u32x4*)(VT + v * ST + NR * ss + 8 * j) = w; } }
            __syncthreads();
            { float pre0 = 0.f, pre1 = 0.f, bm0 = 0.f, bm1 = 0.f, be0 = 0.f, be1 = 0.f;
#pragma unroll
              for (int s = 0; s < 8; ++s) { const f32x2_t t = *(const f32x2_t*)(SEG + (s * 64 + kp) * 2);
                  if (s < seg) { pre0 += t.x; pre1 += t.y; } if (s < 4) { bm0 += t.x; bm1 += t.y; } be0 += t.x; be1 += t.y; }
              float ep0 = cexp2(bm0 - (pre0 + cs0[0] - lf0[0])), ep1 = cexp2(bm1 - (pre1 + cs1[0] - lf1[0]));
              unsigned kw[8];
#pragma unroll
              for (int i = 0; i < 8; ++i) { const int tau = 8 * seg + i;
                  const float e0 = cexp2(bm0 - (pre0 + cs0[i])), e1 = cexp2(bm1 - (pre1 + cs1[i]));
                  *(unsigned*)(QR + tau * SQ + 2 * kp) = cvtpk(bflo(qw[i]) * __builtin_amdgcn_rcpf(e0), bfhi(qw[i]) * __builtin_amdgcn_rcpf(e1));
                  kw[i] = cvtpk(e0 - ep0, e1 - ep1); *(unsigned*)(KR + tau * SQ + 2 * kp) = kw[i]; ep0 = e0; ep1 = e1; }
              u32x4 r0, r1;
              r0.x = (kw[0] & 0xffffu) | (kw[1] << 16); r0.y = (kw[2] & 0xffffu) | (kw[3] << 16); r0.z = (kw[4] & 0xffffu) | (kw[5] << 16); r0.w = (kw[6] & 0xffffu) | (kw[7] << 16);
              r1.x = (kw[0] >> 16) | (kw[1] & 0xffff0000u); r1.y = (kw[2] >> 16) | (kw[3] & 0xffff0000u); r1.z = (kw[4] >> 16) | (kw[5] & 0xffff0000u); r1.w = (kw[6] >> 16) | (kw[7] & 0xffff0000u);
              *(u32x4*)(KRT + (2 * kp) * ST + 8 * seg) = r0; *(u32x4*)(KRT + (2 * kp + 1) * ST + 8 * seg) = r1;
              if (seg == 0) { *(f32x2_t*)(EMID + 2 * kp) = (f32x2_t){cexp2(bm0), cexp2(bm1)}; *(f32x2_t*)(EEND + 2 * kp) = (f32x2_t){cexp2(be0 - bm0), cexp2(be1 - bm1)}; } }
            __syncthreads();
            { const f32x4 em = *(const f32x4*)(EMID + 16 * wave + 4 * rq);
#pragma unroll
              for (int vb = 0; vb < NVB; ++vb) { S[vb] = S[vb] * em; u32x2 w; w.x = cvtpk(S[vb][0], S[vb][1]); w.y = cvtpk(S[vb][2], S[vb][3]);
                  *(u32x2*)(SPT + (16 * vb + l16) * SQ + 16 * wave + 4 * rq) = w; } }
            { const int tb = wave >> 1;
#pragma unroll
              for (int sbi = 0; sbi < 2; ++sbi) { const int sb = 2 * (wave & 1) + sbi; f32x4 acc = {0.f, 0.f, 0.f, 0.f};
                  if (sb <= tb) {
#pragma unroll
                      for (int st = 0; st < 4; ++st) { const bf16x8 a = *(const bf16x8*)(KR + (16 * sb + l16) * SQ + 8 * rq + 32 * st), b = *(const bf16x8*)(QR + (16 * tb + l16) * SQ + 8 * rq + 32 * st); acc = MFMA16(a, b, acc); }
                      const int t = 16 * tb + l16, s0 = 16 * sb + 4 * rq;
#pragma unroll
                      for (int r = 0; r < 4; ++r) acc[r] = (s0 + r <= t) ? acc[r] : 0.f;
                  }
                  u32x2 w; w.x = cvtpk(acc[0], acc[1]); w.y = cvtpk(acc[2], acc[3]);
                  *(u32x2*)(AM + (16 * tb + l16) * ST + 16 * sb + 4 * rq) = w; } }
            __syncthreads();
            { const int tb = wave >> 1; const size_t orow = (size_t)SC_TOK(c, 16 * tb + l16) * D;
#pragma unroll
              for (int vbi = 0; vbi < NVB / 2; ++vbi) { const int vb = (NVB / 2) * (wave & 1) + vbi; f32x4 acc = {0.f, 0.f, 0.f, 0.f};
#pragma unroll
                  for (int st = 0; st < 4; ++st) { const bf16x8 a = *(const bf16x8*)(SPT + (16 * vb + l16) * SQ + 8 * rq + 32 * st), b = *(const bf16x8*)(QR + (16 * tb + l16) * SQ + 8 * rq + 32 * st); acc = MFMA16(a, b, acc); }
#pragma unroll
                  for (int st = 0; st < 2; ++st) { const bf16x8 a = *(const bf16x8*)(VT + (16 * vb + l16) * ST + 8 * rq + 32 * st), b = *(const bf16x8*)(AM + (16 * tb + l16) * ST + 8 * rq + 32 * st); acc = MFMA16(a, b, acc); }
                  u32x2 w; w.x = cvtpk(acc[0], acc[1]); w.y = cvtpk(acc[2], acc[3]);
                  *(u32x2*)(Oo + orow + 16 * vb + 4 * rq) = w; } }
            { const bf16x8 a0 = *(const bf16x8*)(KRT + (16 * wave + l16) * ST + 8 * rq), a1 = *(const bf16x8*)(KRT + (16 * wave + l16) * ST + 8 * rq + 32);
              const f32x4 ee = *(const f32x4*)(EEND + 16 * wave + 4 * rq);
#pragma unroll
              for (int vb = 0; vb < NVB; ++vb) { const bf16x8 b0 = *(const bf16x8*)(VT + (16 * vb + l16) * ST + 8 * rq), b1 = *(const bf16x8*)(VT + (16 * vb + l16) * ST + 8 * rq + 32);
                  S[vb] = MFMA16(a0, b0, S[vb]); S[vb] = MFMA16(a1, b1, S[vb]); S[vb] = S[vb] * ee; } }
            __syncthreads();
        }
#undef SC_LOAD
#undef SC_TOK
    }
}
DI void combine_phase(const bf16* OF, const bf16* OB, const bf16* P, const float* gn, bf16* AOh, int tid) {
    const int lane = tid & 63, wave = tid >> 6, gw = blockIdx.x * NW + wave, ngw = gridDim.x * NW;
    float gv[16];
#pragma unroll
    for (int i = 0; i < 16; ++i) gv[i] = gn[16 * lane + i];
    for (int row = gw; row < HTOK; row += ngw) {
        const u32x4* pf = (const u32x4*)(OF + (size_t)row * D + 16 * lane); const u32x4* pb = (const u32x4*)(OB + (size_t)row * D + 16 * lane);
        const u32x4* pg = (const u32x4*)(P + (size_t)row * 5120 + 2048 + 16 * lane);
        const u32x4 f0 = pf[0], f1 = pf[1], b0 = pb[0], b1 = pb[1], g0 = pg[0], g1 = pg[1];
        const unsigned fw[8] = {f0.x, f0.y, f0.z, f0.w, f1.x, f1.y, f1.z, f1.w}, bw[8] = {b0.x, b0.y, b0.z, b0.w, b1.x, b1.y, b1.z, b1.w}, gw8[8] = {g0.x, g0.y, g0.z, g0.w, g1.x, g1.y, g1.z, g1.w};
        float o[16]; float ss = 0.f;
#pragma unroll
        for (int i = 0; i < 8; ++i) { o[2 * i] = bflo(fw[i]) + bflo(bw[i]); o[2 * i + 1] = bfhi(fw[i]) + bfhi(bw[i]); ss += o[2 * i] * o[2 * i] + o[2 * i + 1] * o[2 * i + 1]; }
        ss += __shfl_xor(ss, 1); ss += __shfl_xor(ss, 2); ss += __shfl_xor(ss, 4);
        const float rstd = 1.0f / sqrtf(ss * (1.0f / 128.0f) + EPS);
        unsigned ow[8];
#pragma unroll
        for (int i = 0; i < 8; ++i) { const float ga = bflo(gw8[i]), gb = bfhi(gw8[i]);
            const float ya = o[2 * i] * rstd * gv[2 * i] * (ga * pg8::fast_sigmoid(ga)), yb = o[2 * i + 1] * rstd * gv[2 * i + 1] * (gb * pg8::fast_sigmoid(gb));
            ow[i] = cvtpk(ya, yb); }
        u32x4* po = (u32x4*)(AOh + (size_t)row * D + 16 * lane);
        po[0] = (u32x4){ow[0], ow[1], ow[2], ow[3]}; po[1] = (u32x4){ow[4], ow[5], ow[6], ow[7]};
    }
}

#define XB_TMO      128
#define XB_XCNT(j)  (256  + 64 * (j))
#define XB_XSUB(j)  (1280 + 64 * (j))
#define XB_XGEN(j)  (2304 + 64 * (j))
#define XB_TOP      3328
#define XB_TOPGEN   3392
#define XCD_BAR_WORDS 3456
#define XB_SPIN_CAP (1u << 18)

__device__ __forceinline__ unsigned xb_ld(unsigned* p)              { return __hip_atomic_load(p, __ATOMIC_RELAXED, __HIP_MEMORY_SCOPE_AGENT); }
__device__ __forceinline__ unsigned xb_add(unsigned* p, unsigned v) { return __hip_atomic_fetch_add(p, v, __ATOMIC_RELAXED, __HIP_MEMORY_SCOPE_AGENT); }
__device__ __forceinline__ unsigned xb_xcc_id() { return (unsigned)__builtin_amdgcn_s_getreg((3 << 11) | 20) & 0xFu; }
#define XB_SPIN(cond, bar) do { unsigned _sp = 0; while (cond) { __builtin_amdgcn_s_sleep(1); \
    if ((++_sp & 255u) == 0u) { if (xb_ld(&(bar)[XB_TMO])) break; if (_sp > XB_SPIN_CAP) { atomicAdd(&(bar)[XB_TMO], 1u); break; } } } } while (0)

struct XcdBarrier {
    unsigned* bar; unsigned x;
    volatile LAS unsigned* st;
};

__device__ __forceinline__ XcdBarrier xcd_barrier_post(unsigned* bar, volatile LAS unsigned* st) {
    XcdBarrier b; b.bar = bar; b.x = xb_xcc_id(); b.st = st;
    if (threadIdx.x == 0) (void)xb_add(&bar[XB_XCNT(b.x)], 1u);
    return b;
}
__device__ __forceinline__ void xcd_barrier_complete(unsigned* bar, unsigned x, unsigned& nloc, unsigned& nx) {
    const unsigned G = gridDim.x * gridDim.y * gridDim.z;
    unsigned sum, cnt, mine, sp = 0u;
    for (;;) {
        sum = 0u; cnt = 0u; mine = 0u;
#pragma unroll
        for (unsigned j = 0; j < 16; ++j) { const unsigned c = xb_ld(&bar[XB_XCNT(j)]); sum += c; cnt += (c > 0u) ? 1u : 0u; mine = (j == x) ? c : mine; }
        if (sum == G) break;
        __builtin_amdgcn_s_sleep(1);
        if ((++sp & 255u) == 0u) { if (xb_ld(&bar[XB_TMO])) break; if (sp > XB_SPIN_CAP) { atomicAdd(&bar[XB_TMO], 1u); break; } }
    }
    nloc = mine > 0u ? mine : 1u; nx = cnt > 0u ? cnt : 1u;
}

__device__ __forceinline__ void xcd_barrier(const XcdBarrier& b) {
    asm volatile("s_waitcnt vmcnt(0)" ::: "memory");
    __syncthreads();
    if (threadIdx.x == 0) {
        unsigned* bar = b.bar;
        __builtin_amdgcn_s_waitcnt(0);
        unsigned nloc = b.st[0], nx = b.st[1];
        if (nloc == 0u) { xcd_barrier_complete(bar, b.x, nloc, nx); b.st[0] = nloc; b.st[1] = nx; }
        const unsigned old = xb_add(&bar[XB_XSUB(b.x)], 1u);
        const unsigned gen = old / nloc;
        if (old + 1u == (gen + 1u) * nloc) {
            __builtin_amdgcn_fence(__ATOMIC_RELEASE, "agent");
            asm volatile("s_waitcnt vmcnt(0)" ::: "memory");
            const unsigned og = xb_add(&bar[XB_TOP], 1u);
            const unsigned tg = og / nx;
            if (og + 1u == (tg + 1u) * nx) xb_add(&bar[XB_TOPGEN], 1u);
            else XB_SPIN(xb_ld(&bar[XB_TOPGEN]) == tg, bar);
            __builtin_amdgcn_fence(__ATOMIC_ACQUIRE, "agent");
            xb_add(&bar[XB_XGEN(b.x)], 1u);
            asm volatile("s_waitcnt vmcnt(0)" ::: "memory");
        } else {
            XB_SPIN(xb_ld(&bar[XB_XGEN(b.x)]) == gen, bar);
            __builtin_amdgcn_fence(__ATOMIC_ACQUIRE, "agent");
            asm volatile("s_waitcnt vmcnt(0)" ::: "memory");
        }
    }
    __syncthreads();
}

template <bool COLS> DI const float* prep_rstd(unsigned char* lds, const float* ssq, int M, int N, int tid) {
    float* tab = (float*)(lds + 131072); int* list = (int*)(lds + 131072 + 23552);
    int bx = blockIdx.x; asm volatile("" : "+s"(bx));
    pg8::StaticOrder S; S.init(M, N, (int)gridDim.x, bx); pg8::Unit u;
    int n = 0;
    for (int i = 0; S.next(i, u); ++i) { if (tid == 0) list[i] = COLS ? u.pn : u.pm; ++n; }
    __syncthreads();
#pragma unroll 4
    for (int e = tid; e < n * 256; e += 512) tab[e] = pg8::rstd_row(ssq, list[e >> 8] * 256 + (e & 255));
    __syncthreads();
    return tab;
}
DI void stagger(int slots, int ticks) {
    const int k = (int)(blockIdx.x >> 3) % slots;
    if (k) { const unsigned long long t0 = __builtin_amdgcn_s_memrealtime(); while (__builtin_amdgcn_s_memrealtime() - t0 < (unsigned long long)(k * ticks)) __builtin_amdgcn_s_sleep(8); }
}
template <class Epi> DI void run_gemm(unsigned char* lds, const bf16* A, const bf16* Bt, int M, int N, int K, const Epi& E, int tid) {
    int bx = blockIdx.x; asm volatile("" : "+s"(bx));
    pg8::Gemm g{A, Bt, M, N, K}; pg8::StaticOrder S; S.init(M, N, (int)gridDim.x, bx);
    pg8::gemm_phase<Epi, pg8::StaticOrder, GEMM_ALIGN, GEMM_SP2>((LAS unsigned char*)lds, g, S, E, tid);
    __syncthreads();
}

__global__ void __launch_bounds__(512, 2) fwd(Args a) {
    extern __shared__ __attribute__((aligned(16))) unsigned char lds[];
    cg::grid_group grid = cg::this_grid();
    volatile LAS unsigned* bst = (volatile LAS unsigned*)((LAS unsigned char*)lds + LDS_BYTES - 16);
    if (threadIdx.x < 2) bst[threadIdx.x] = 0u;
    __syncthreads();
    const XcdBarrier xbar = xcd_barrier_post((unsigned*)(a.ws + WS_BAR), bst);
    unsigned char* ws0 = a.ws;
    const In& I = a.in;
    const int lo = a.lo, hi = a.hi;
    int pc = 0;
#ifndef REP_NORM
#define REP_NORM 1
#endif
#ifndef REP_SCAN
#define REP_SCAN 1
#endif
#ifndef REP_ATTN
#define REP_ATTN 1
#endif
#ifndef REP_FFN1
#define REP_FFN1 1
#endif
#define PTR(k) (((const float* const*)(ws + WS_PTR))[k])
#ifndef STAG_SLOTS
#define STAG_SLOTS 1
#endif
#ifndef STAG_TICKS
#define STAG_TICKS 800
#endif
#ifndef REP_FFN2
#define REP_FFN2 1
#endif
#ifndef REP_HG
#define REP_HG 1
#endif
#ifndef GEMM_SP2
#define GEMM_SP2 true
#endif
#ifndef REP_MISC
#define REP_MISC 1
#endif
#ifndef REP_WO
#define REP_WO 1
#endif
#ifndef REP_SYNC
#define REP_SYNC 1
#endif
#define PH_BEGIN if (pc >= lo && pc < hi) { int tid = threadIdx.x; asm volatile("" : "+v"(tid)); unsigned char* ws = ws0; asm volatile("" : "+s"(ws)); bf16* XB = (bf16*)(ws + WS_XN); bf16* AR = (bf16*)(ws + WS_AR); float* SSQ = (float*)(ws + WS_SSQ); bf16* AO = AO0; asm volatile("" : "+s"(AO)); bf16* OF = AO + (size_t)NTOK * D; bf16* OB = OF + (size_t)HTOK * D; bf16* VT = (bf16*)(ws + WS_AR + AR_VT);
#define PH_END if (pc + 1 < hi) { for (int rs_ = 0; rs_ < REP_SYNC; ++rs_) { if (pc == 0) grid.sync(); else xcd_barrier(xbar); } } } ++pc;

    bf16* AO0 = (bf16*)a.out;
    PH_BEGIN if (blockIdx.x == 0 && tid == 0) { const float** pt = (const float**)(ws + WS_PTR); pt[0] = I.hg_gn; pt[1] = I.sw_sink; pt[2] = I.na_rpb; pt[3] = I.fin_g; }
             for (int rp_ = 0; rp_ < REP_MISC; ++rp_) { conv_phase(I, ws, a.inv, lds, tid); first_phase(I.xp, I.xs, XB, SSQ, tid); } PH_END
    for (int li = 0; li < 4; ++li) {
        for (int sub = 0; sub < 3; ++sub) {
            if (sub != 1) {
                const int fi = li * 2 + (sub >> 1);
                #ifdef SPLIT_FFN1
                PH_BEGIN for (int hh_ = 0; hh_ < 2; ++hh_) { pg8::EpiSwiglu E{AR + (size_t)hh_ * HTOK * DFF, DFF, prep_rstd<false>(lds, SSQ + (size_t)hh_ * HTOK * 16, HTOK, 2 * DFF, tid)}; run_gemm(lds, XB + (size_t)hh_ * HTOK * D, (const bf16*)(ws + WS_W1) + (size_t)fi * 2 * DFF * D, HTOK, 2 * DFF, D, E, tid); if (hh_ == 0) xcd_barrier(xbar); } PH_END
#else
                PH_BEGIN for (int rp_ = 0; rp_ < REP_FFN1; ++rp_) { pg8::EpiSwiglu E{AR, DFF, prep_rstd<false>(lds, SSQ, NTOK, 2 * DFF, tid)}; run_gemm(lds, XB, (const bf16*)(ws + WS_W1) + (size_t)fi * 2 * DFF * D, NTOK, 2 * DFF, D, E, tid); } PH_END
#endif
                PH_BEGIN for (int rp_ = 0; rp_ < REP_FFN2; ++rp_) { pg8::EpiResid E{XB, (rp_ == REP_FFN2 - 1) ? 0.5f : 0.0f, SSQ}; run_gemm(lds, AR, (const bf16*)(ws + WS_W2) + (size_t)fi * D * DFF, NTOK, D, DFF, E, tid); } PH_END
            } else {
                const int kind = li % 3;
                if (kind == 0) {
                    const int ia = li / 3;
                    for (int half = 0; half < 2; ++half) {
                        PH_BEGIN for (int rp_ = 0; rp_ < REP_HG; ++rp_) { pg8::EpiHg E{AR, (const float*)(ws + WS_LB) + li * 2048, prep_rstd<false>(lds, SSQ + (size_t)half * HTOK * 16, HTOK, 5 * D, tid)}; run_gemm(lds, XB + (size_t)half * HTOK * D, (const bf16*)(ws + WS_HGIN) + (size_t)ia * 5 * D * D, HTOK, 5 * D, D, E, tid); } PH_END
                        PH_BEGIN for (int rp_ = 0; rp_ < REP_SCAN; ++rp_) { if (half == 0) scan_phase<64>(AR, OF, OB, 0, lds, tid); else scan_phase<128>(AR, OF, OB, 1, lds, tid); } PH_END
                        PH_BEGIN for (int rp_ = 0; rp_ < REP_MISC; ++rp_) combine_phase(OF, OB, AR, PTR(0) + ia * D, AO + (size_t)half * HTOK * D, tid); PH_END
                    }
                    PH_BEGIN for (int rp_ = 0; rp_ < REP_WO; ++rp_) { pg8::EpiResid E{XB, (rp_ == REP_WO - 1) ? 1.0f : 0.0f, SSQ}; run_gemm(lds, AO, (const bf16*)(ws + WS_HGO) + (size_t)ia * D * D, NTOK, D, D, E, tid); } PH_END
                } else if (kind == 1) {
                    PH_BEGIN { pg8::EpiStore<false> E{AR, 1280, prep_rstd<false>(lds, SSQ, NTOK, 1280, tid)}; run_gemm(lds, XB, (const bf16*)(ws + WS_SWQKV), NTOK, 1280, D, E, tid); }
                             { pg8::EpiStore<true> E{VT, NTOK, prep_rstd<true>(lds, SSQ, 256, NTOK, tid)}; run_gemm(lds, (const bf16*)(ws + WS_SWQKV) + (size_t)1280 * D, XB, 256, NTOK, D, E, tid); } PH_END
                    PH_BEGIN for (int rp_ = 0; rp_ < REP_ATTN; ++rp_) swa_phase(AR, VT, AO, PTR(1), (const float*)(ws + WS_ROPE), lds, tid); PH_END
                    PH_BEGIN for (int rp_ = 0; rp_ < REP_WO; ++rp_) { pg8::EpiResid E{XB, (rp_ == REP_WO - 1) ? 1.0f : 0.0f, SSQ}; run_gemm(lds, AO, (const bf16*)(ws + WS_SWO), NTOK, D, D, E, tid); } PH_END
                } else {
                    PH_BEGIN { pg8::EpiStore<false> E{AR, 2048, prep_rstd<false>(lds, SSQ, NTOK, 2048, tid)}; run_gemm(lds, XB, (const bf16*)(ws + WS_NAQKV), NTOK, 2048, D, E, tid); }
                             { pg8::EpiStore<true> E{VT, NTOK, prep_rstd<true>(lds, SSQ, D, NTOK, tid)}; run_gemm(lds, (const bf16*)(ws + WS_NAQKV) + (size_t)2048 * D, XB, D, NTOK, D, E, tid); } PH_END
                    PH_BEGIN for (int rp_ = 0; rp_ < REP_ATTN; ++rp_) na_phase(AR, VT, AO, PTR(2), lds, tid); PH_END
                    PH_BEGIN for (int rp_ = 0; rp_ < REP_WO; ++rp_) { pg8::EpiResid E{XB, (rp_ == REP_WO - 1) ? 1.0f : 0.0f, SSQ}; run_gemm(lds, AO, (const bf16*)(ws + WS_NAO), NTOK, D, D, E, tid); } PH_END
                }
            }
        }
    }
    PH_BEGIN for (int rp_ = 0; rp_ < REP_MISC; ++rp_) final_phase(XB, SSQ, PTR(3), (float*)AO, tid); PH_END
}
constexpr int NPHASES = 1 + 4 * 4 + (7 + 3 + 3 + 7) + 1;

#ifndef MULTI_LAUNCH
#define MULTI_LAUNCH 0
#endif
extern "C" void kernel_launch(void* const* d_in, const int* in_sizes, int n_in, void* d_out, int out_size, void* d_ws, size_t ws_size, hipStream_t stream) {
    static int grid = 0;
    if (grid == 0) {
        if (n_in != 16 || out_size != NTOK * D || ws_size < WS_NEED) { fprintf(stderr, "kernel_launch: unexpected shapes (n_in %d out %d ws %zu)\n", n_in, out_size, ws_size); grid = -1; return; }
        int dev = 0, cus = 0, per_cu = 0;
        hipGetDevice(&dev); hipDeviceGetAttribute(&cus, hipDeviceAttributeMultiprocessorCount, dev);
        if (hipFuncSetAttribute((const void*)fwd, hipFuncAttributeMaxDynamicSharedMemorySize, LDS_BYTES) != hipSuccess) { fprintf(stderr, "kernel_launch: hipFuncSetAttribute failed\n"); grid = -1; return; }
        if (hipOccupancyMaxActiveBlocksPerMultiprocessor(&per_cu, (const void*)fwd, 512, LDS_BYTES) != hipSuccess || per_cu < 1) { fprintf(stderr, "kernel_launch: occupancy query says %d\n", per_cu); per_cu = 1; }
        (void)hipGetLastError();
        grid = cus * per_cu;
    }
    if (grid < 0) return;
    Args a; memset(&a, 0, sizeof(a));
    const float** ip = (const float**)&a.in;
    for (int i = 0; i < 16; ++i) ip[i] = (const float*)d_in[i];
    a.out = (float*)d_out; a.ws = (unsigned char*)d_ws;
    for (int j = 0; j < 8; ++j) a.inv[j] = exp(-(double)j * (2.0 / 16.0) * log(500000.0));
#if MULTI_LAUNCH
    for (int p = 0; p < NPHASES; ++p) { a.lo = p; a.hi = p + 1; hipLaunchKernelGGL(fwd, dim3(grid), dim3(512), LDS_BYTES, stream, a); }
#else
    a.lo = 0; a.hi = NPHASES;
    (void)hipMemsetAsync((unsigned char*)d_ws + WS_BAR, 0, 16384, stream);
    void* args[] = {&a};
    hipError_t e = hipLaunchCooperativeKernel((const void*)fwd, dim3(grid), dim3(512), args, LDS_BYTES, stream);
    if (e != hipSuccess) fprintf(stderr, "cooperative launch failed: %s (grid %d)\n", hipGetErrorString(e), grid);
#endif
}
```

```cpp
#include <hip/hip_runtime.h>
#include <hip/hip_cooperative_groups.h>
#include <cstdio>
#include <cstdint>
#include <cstring>
#include <cmath>
namespace cg = cooperative_groups;
#ifndef GEMM_WGM
#define GEMM_WGM 8
#endif
namespace pg8 {
#define PG8_LAS __attribute__((address_space(3)))
typedef unsigned short bf16_t;
typedef short bf16x8 __attribute__((ext_vector_type(8)));
typedef float f32x4 __attribute__((ext_vector_type(4)));
typedef unsigned u32x4 __attribute__((ext_vector_type(4)));
constexpr int BM = 256, BK = 64, HALF = 128, HTB = HALF * BK * 2  , STAGE_BYTES = 8 * HTB, NXCD = 8, WGM = GEMM_WGM;

__host__ __device__ __forceinline__ int lds_byte(int r, int c) { const int st = (r >> 4) * 2 + (c >> 5), rr = r & 15, cc = c & 31, ob = rr * 64 + cc * 2; return st * 1024 + (ob ^ (((ob >> 9) & 1) << 5)); }
__host__ __device__ __forceinline__ void stage_rc(int b, int& R, int& C) { const int st = b / 1024, sb = b % 1024, swz = sb ^ (((sb >> 9) & 1) << 5); R = (st >> 1) * 16 + swz / 64; C = (st & 1) * 32 + (swz % 64) / 2; }
__host__ __device__ __forceinline__ int perm32(int rho) { const int n = rho >> 4, i = rho & 15; return 8 * (i >> 2) + 4 * n + (i & 3); }

struct Unit { int pm, pn, ord; };
struct Gemm { const bf16_t* A; const bf16_t* Bt; int M, N, K; };

struct StaticOrder {
    int nM, nN, nwg, G, c;
    __host__ __device__ void init(int M, int N, int G_, int c_) { nM = M / BM; nN = N / BM; nwg = nM * nN; G = G_; c = c_; }
    __host__ __device__ bool next(int i, Unit& u) const {
        const long L = (long)i * G + c; if (L >= nwg) return false; u.ord = i;
        int wgid = (int)L; { const int q = nwg / NXCD, r = nwg % NXCD, xcd = wgid % NXCD, off = wgid / NXCD; wgid = (xcd < r ? xcd * (q + 1) : r * (q + 1) + (xcd - r) * q) + off; }
        const int nig = WGM * nN, gid = wgid / nig, fm = gid * WGM, gsz = (nM - fm) < WGM ? (nM - fm) : WGM;
        u.pm = fm + ((wgid % nig) % gsz); u.pn = (wgid % nig) / gsz; return true;
    }
    __device__ __forceinline__ void a_ready(const Unit&) const {}
    __device__ __forceinline__ void done(const Unit&) const {}
};

typedef float f32x2c __attribute__((ext_vector_type(2))); typedef __bf16 bf16x2c __attribute__((ext_vector_type(2)));
__device__ __forceinline__ unsigned cvt_pk_bf16(float lo, float hi) { const f32x2c v = {lo, hi}; const bf16x2c b = __builtin_convertvector(v, bf16x2c); return __builtin_bit_cast(unsigned, b); }
typedef float f32x2 __attribute__((ext_vector_type(2)));
__device__ __forceinline__ float fast_sigmoid(float x) { return __builtin_amdgcn_rcpf(1.0f + __expf(-x)); }
__device__ __forceinline__ float rstd_row(const float* part, int row) { const f32x4* p = (const f32x4*)(part + (size_t)row * 16); const f32x4 a = p[0], b = p[1], c = p[2], d = p[3];
    const float ss = ((a[0] + a[1]) + (a[2] + a[3])) + ((b[0] + b[1]) + (b[2] + b[3])) + ((c[0] + c[1]) + (c[2] + c[3])) + ((d[0] + d[1]) + (d[2] + d[3]));
    return __builtin_amdgcn_rsqf(ss * (1.0f / 1024.0f) + 1e-6f); }
struct EpiSwiglu {
    static constexpr bool PERM = true, AFTER_DRAIN = false;
    bf16_t* H; int ldh; const float* rtab;
    __device__ __forceinline__ void operator()(const f32x4 (&acc)[2][2][4][2], const Unit& u, int wr, int wc, int fr, int fq) const {
        const int row0 = u.pm * BM + wr * 64 + fr, col0 = u.pn * HALF + wc * 32 + 8 * fq;
#pragma unroll
        for (int ai = 0; ai < 2; ++ai)
#pragma unroll
            for (int m = 0; m < 4; ++m) {
                const int row = row0 + ai * HALF + m * 16;
                bf16_t* rowp = H + (size_t)row * ldh + col0;
                const float rs = rtab[u.ord * 256 + wr * 64 + fr + ai * HALF + m * 16];
                const float nrl = rs * -1.4426950408889634f, rs2 = rs * rs;
                unsigned w[4];
#pragma unroll
                for (int n = 0; n < 2; ++n)
#pragma unroll
                    for (int p = 0; p < 2; ++p) {
                        const f32x2 g = {acc[ai][0][m][n][2 * p], acc[ai][0][m][n][2 * p + 1]}, up = {acc[ai][1][m][n][2 * p], acc[ai][1][m][n][2 * p + 1]};
                        const f32x2 a = g * nrl; f32x2 d; d.x = __builtin_amdgcn_exp2f(a.x); d.y = __builtin_amdgcn_exp2f(a.y);
                        d = d + 1.0f; f32x2 r; r.x = __builtin_amdgcn_rcpf(d.x); r.y = __builtin_amdgcn_rcpf(d.y);
                        const f32x2 h = ((g * up) * rs2) * r;
                        w[2 * n + p] = cvt_pk_bf16(h.x, h.y); }
                u32x4 wv = {w[0], w[1], w[2], w[3]};
                __builtin_nontemporal_store(wv, (u32x4*)rowp);
            }
    }
};
struct EpiResid {
    static constexpr bool PERM = true, AFTER_DRAIN = false;
    bf16_t* XB; float scale; float* ssq;
    __device__ __forceinline__ void operator()(const f32x4 (&acc)[2][2][4][2], const Unit& u, int wr, int wc, int fr, int fq) const {
        const int row0 = u.pm * BM + wr * 64 + fr, col0 = u.pn * BM + wc * 32 + 8 * fq;
        bf16_t* xb = XB + (size_t)row0 * 1024 + col0;
        u32x4 xo[8][2];
#pragma unroll
        for (int g = 0; g < 8; ++g) { const bf16_t* p_ = xb + (size_t)((g >> 2) * HALF + (g & 3) * 16) * 1024; xo[g][0] = *(const u32x4*)(p_); xo[g][1] = *(const u32x4*)(p_ + HALF); }
#pragma unroll
        for (int g = 0; g < 8; ++g) {
            const int ai = g >> 2, m = g & 3;
            const int row = row0 + ai * HALF + m * 16;
            bf16_t* rowp = XB + (size_t)row * 1024 + col0;
            float part = 0.f;
#pragma unroll
            for (int bj = 0; bj < 2; ++bj) {
                const unsigned w[4] = {xo[g][bj][0], xo[g][bj][1], xo[g][bj][2], xo[g][bj][3]};
                float t[8];
#pragma unroll
                for (int i = 0; i < 4; ++i) { t[2 * i] = __uint_as_float(w[i] << 16) + acc[ai][bj][m][i >> 1][(2 * i) & 3] * scale; t[2 * i + 1] = __uint_as_float(w[i] & 0xffff0000u) + acc[ai][bj][m][i >> 1][(2 * i + 1) & 3] * scale; }
#pragma unroll
                for (int i = 0; i < 8; ++i) part += t[i] * t[i];
                u32x4 o; o.x = cvt_pk_bf16(t[0], t[1]); o.y = cvt_pk_bf16(t[2], t[3]); o.z = cvt_pk_bf16(t[4], t[5]); o.w = cvt_pk_bf16(t[6], t[7]);
                *(u32x4*)(rowp + bj * HALF) = o;
            }
            part += __shfl_xor(part, 16); part += __shfl_xor(part, 32);
            if (fq == 0) ssq[(size_t)row * 16 + u.pn * 4 + wc] = part;
        }
    }
};
template <bool COLS> struct EpiStore {
    static constexpr bool PERM = true, AFTER_DRAIN = false;
    bf16_t* O; size_t ldo; const float* rtab;
    __device__ __forceinline__ void operator()(const f32x4 (&acc)[2][2][4][2], const Unit& u, int wr, int wc, int fr, int fq) const {
        const int row0 = u.pm * BM + wr * 64 + fr, col0 = u.pn * BM + wc * 32 + 8 * fq;
        f32x4 cs[2][2];
        if (COLS) {
#pragma unroll
            for (int bj = 0; bj < 2; ++bj)
#pragma unroll
                for (int n = 0; n < 2; ++n) cs[bj][n] = *(const f32x4*)(rtab + u.ord * 256 + wc * 32 + 8 * fq + bj * HALF + 4 * n);
        }
#pragma unroll
        for (int ai = 0; ai < 2; ++ai)
#pragma unroll
            for (int m = 0; m < 4; ++m) {
                const int row = row0 + ai * HALF + m * 16;
                bf16_t* rowp = O + (size_t)row * ldo + col0;
                const float rs = COLS ? 1.0f : rtab[u.ord * 256 + wr * 64 + fr + ai * HALF + m * 16];
#pragma unroll
                for (int bj = 0; bj < 2; ++bj) { const f32x4 v0 = COLS ? acc[ai][bj][m][0] * cs[bj][0] : acc[ai][bj][m][0] * rs, v1 = COLS ? acc[ai][bj][m][1] * cs[bj][1] : acc[ai][bj][m][1] * rs;
                    u32x4 w; w.x = cvt_pk_bf16(v0[0], v0[1]); w.y = cvt_pk_bf16(v0[2], v0[3]); w.z = cvt_pk_bf16(v1[0], v1[1]); w.w = cvt_pk_bf16(v1[2], v1[3]);
                    *(u32x4*)(rowp + bj * HALF) = w; }
            }
    }
};
__device__ __forceinline__ unsigned pk_f16(float a, float b) { const _Float16 ha = (_Float16)a, hb = (_Float16)b; return (unsigned)__builtin_bit_cast(unsigned short, ha) | ((unsigned)__builtin_bit_cast(unsigned short, hb) << 16); }
struct EpiHg {
    static constexpr bool PERM = true, AFTER_DRAIN = false;
    bf16_t* O; const float* lb; const float* rtab;
    __device__ __forceinline__ void operator()(const f32x4 (&acc)[2][2][4][2], const Unit& u, int wr, int wc, int fr, int fq) const {
        const int row0 = u.pm * BM + wr * 64 + fr, col0 = u.pn * BM + wc * 32 + 8 * fq;
        const bool gate = (u.pn >= 12);
        f32x4 lbv[2][2];
#pragma unroll
        for (int bj = 0; bj < 2; ++bj)
#pragma unroll
            for (int n = 0; n < 2; ++n) lbv[bj][n] = gate ? *(const f32x4*)(lb + (col0 - 3072) + bj * HALF + 4 * n) : (f32x4){0.f, 0.f, 0.f, 0.f};
#pragma unroll
        for (int ai = 0; ai < 2; ++ai)
#pragma unroll
            for (int m = 0; m < 4; ++m) {
                const int row = row0 + ai * HALF + m * 16;
                bf16_t* rowp = O + (size_t)row * 5120 + col0;
                const float rs = rtab[u.ord * 256 + wr * 64 + fr + ai * HALF + m * 16];
#pragma unroll
                for (int bj = 0; bj < 2; ++bj) { const f32x4 v0 = acc[ai][bj][m][0] * rs, v1 = acc[ai][bj][m][1] * rs;
                    u32x4 w;
                    if (gate) {
                        float o[8];
#pragma unroll
                        for (int e = 0; e < 4; ++e) { const float l0 = lbv[bj][0][e], l1 = lbv[bj][1][e];
                            o[e] = __log2f(l0 + (1.0f - l0) * fast_sigmoid(v0[e])); o[4 + e] = __log2f(l1 + (1.0f - l1) * fast_sigmoid(v1[e])); }
                        w.x = pk_f16(o[0], o[1]); w.y = pk_f16(o[2], o[3]); w.z = pk_f16(o[4], o[5]); w.w = pk_f16(o[6], o[7]);
                    } else { w.x = cvt_pk_bf16(v0[0], v0[1]); w.y = cvt_pk_bf16(v0[2], v0[3]); w.z = cvt_pk_bf16(v1[0], v1[1]); w.w = cvt_pk_bf16(v1[2], v1[3]); }
                    __builtin_nontemporal_store(w, (u32x4*)(rowp + bj * HALF)); }
            }
    }
};
template <class Epi, class Sched, bool ALIGN_EPI = false, bool SP2 = false>
__device__ __forceinline__ void gemm_phase(PG8_LAS unsigned char* lds, const Gemm g, const Sched& S, const Epi& E, const int tid) {
    const int wid = __builtin_amdgcn_readfirstlane(tid >> 6), lane = tid & 63, wr = wid >> 2, wc = wid & 3, fr = lane & 15, fq = lane >> 4;
    const int K = g.K, nt = K / BK;
    unsigned voffA[2], voffB[2];
#pragma unroll
    for (int i = 0; i < 2; ++i) { int R, C; stage_rc(tid * 16 + i * 8192, R, C); const int Rb = Epi::PERM ? ((R & ~31) + perm32(R & 31)) : R;
        voffA[i] = (unsigned)(R * K + C) * 2u; voffB[i] = (unsigned)(Rb * K + C) * 2u; }
    const size_t kstep = (size_t)(BK * 2);
    const size_t hstep = (size_t)HALF * K * 2;
    const size_t tstep = 2 * hstep;
    const unsigned ldsw = (unsigned)wid * 1024u;
    const int aoff = lds_byte(wr * 64 + fr, fq * 8), boff = lds_byte(wc * 32 + fr, fq * 8);
#define PG8_SA(b, h) (((b) * 2 + (h)) * HTB)
#define PG8_SB(b, h) ((4 + (b) * 2 + (h)) * HTB)
#define PG8_STAGE(bufoff, gbase, voff) do { _Pragma("unroll") for (int _i = 0; _i < 2; ++_i) \
        __builtin_amdgcn_global_load_lds((const unsigned*)((const char*)(gbase) + (voff)[_i]), (PG8_LAS unsigned*)(lds + (bufoff) + ldsw + _i * 8192), 16, 0, 0); } while (0)
#define PG8_LDA(dst, b, h) do { _Pragma("unroll") for (int m = 0; m < 4; ++m) _Pragma("unroll") for (int k = 0; k < 2; ++k) dst[m][k] = *(const PG8_LAS bf16x8*)(lds + PG8_SA(b, h) + aoff + m * 2048 + k * 1024); } while (0)
#define PG8_LDB(dst, b, h) do { _Pragma("unroll") for (int n = 0; n < 2; ++n) _Pragma("unroll") for (int k = 0; k < 2; ++k) dst[n][k] = *(const PG8_LAS bf16x8*)(lds + PG8_SB(b, h) + boff + n * 2048 + k * 1024); } while (0)
#define PG8_MMA(ai, bj, At, Bt) do { __builtin_amdgcn_s_setprio(1); _Pragma("unroll") for (int m = 0; m < 4; ++m) _Pragma("unroll") for (int n = 0; n < 2; ++n) _Pragma("unroll") for (int k = 0; k < 2; ++k) \
        acc[ai][bj][m][n] = __builtin_amdgcn_mfma_f32_16x16x32_bf16(Bt[n][k], At[m][k], acc[ai][bj][m][n], 0, 0, 0); __builtin_amdgcn_s_setprio(0); } while (0)
#define PG8_WAIT_V(n) asm volatile("s_waitcnt vmcnt(" #n ")" ::: "memory")
#define PG8_WAIT_L(n) asm volatile("s_waitcnt lgkmcnt(" #n ")" ::: "memory")
#define PG8_BAR __builtin_amdgcn_s_barrier()
#define PG8_SCHED __builtin_amdgcn_sched_barrier(0)
    Unit cur, nxt; int ui = 0;
    if (!S.next(0, cur)) return;
    f32x4 acc[2][2][4][2];
#pragma unroll
    for (int a = 0; a < 2; ++a)
#pragma unroll
        for (int b = 0; b < 2; ++b)
#pragma unroll
            for (int m = 0; m < 4; ++m)
#pragma unroll
                for (int n = 0; n < 2; ++n) acc[a][b][m][n] = (f32x4){0.f, 0.f, 0.f, 0.f};
    bf16x8 At[4][2], B0[2][2], B1[2][2];
    const char* cA = (const char*)g.A + (size_t)cur.pm * tstep; const char* cB = (const char*)g.Bt + (size_t)cur.pn * tstep;
    S.a_ready(cur);
    if constexpr (SP2) {
        PG8_STAGE(PG8_SB(0, 0), cB, voffB); PG8_STAGE(PG8_SB(0, 1), cB + hstep, voffB); PG8_STAGE(PG8_SA(0, 0), cA, voffA); PG8_STAGE(PG8_SA(0, 1), cA + hstep, voffA);
        if (wr == 1) PG8_BAR;
        PG8_WAIT_V(2); PG8_BAR;
        PG8_STAGE(PG8_SB(1, 0), cB + kstep, voffB); PG8_STAGE(PG8_SA(1, 0), cA + kstep, voffA); PG8_STAGE(PG8_SB(1, 1), cB + hstep + kstep, voffB);
        PG8_WAIT_V(6); PG8_BAR;
    } else {
        PG8_STAGE(PG8_SB(0, 0), cB, voffB); PG8_STAGE(PG8_SA(0, 0), cA, voffA); PG8_STAGE(PG8_SB(0, 1), cB + hstep, voffB); PG8_STAGE(PG8_SA(0, 1), cA + hstep, voffA);
        if (wr == 1) PG8_BAR;
        PG8_WAIT_V(4); PG8_BAR;
        PG8_STAGE(PG8_SB(1, 0), cB + kstep, voffB); PG8_STAGE(PG8_SA(1, 0), cA + kstep, voffA); PG8_STAGE(PG8_SB(1, 1), cB + hstep + kstep, voffB);
        PG8_WAIT_V(6); PG8_BAR;
    }
    for (;;) {
        const bool has_next = S.next(ui + 1, nxt);
        const char* nA = has_next ? (const char*)g.A + (size_t)nxt.pm * tstep : cA; const char* nB = has_next ? (const char*)g.Bt + (size_t)nxt.pn * tstep : cB;
        for (int t = 0; t < nt; t += 2) {
            const bool last = (t == nt - 2);
            const char* a1 = cA + (size_t)(t + 1) * kstep;
            const char* a2 = last ? nA : cA + (size_t)(t + 2) * kstep; const char* b2 = last ? nB : cB + (size_t)(t + 2) * kstep;
            const char* a3 = a2 + kstep; const char* b3 = b2 + kstep;
            if (last && has_next) S.a_ready(nxt);
            if constexpr (SP2) {
            PG8_LDB(B0, 0, 0); PG8_LDB(B1, 0, 1); PG8_SCHED; PG8_LDA(At, 0, 0); PG8_STAGE(PG8_SA(1, 1), a1 + hstep, voffA);
            PG8_WAIT_V(8); PG8_WAIT_L(0); PG8_BAR; PG8_MMA(0, 0, At, B0); PG8_MMA(0, 1, At, B1); PG8_BAR; PG8_SCHED;
            PG8_LDA(At, 0, 1); PG8_STAGE(PG8_SB(0, 0), b2, voffB); PG8_STAGE(PG8_SB(0, 1), b2 + hstep, voffB); PG8_STAGE(PG8_SA(0, 0), a2, voffA);
            PG8_WAIT_V(8); PG8_WAIT_L(0); PG8_BAR; PG8_MMA(1, 0, At, B0); PG8_MMA(1, 1, At, B1); PG8_BAR; PG8_SCHED;
            PG8_LDB(B0, 1, 0); PG8_LDB(B1, 1, 1); PG8_SCHED; PG8_LDA(At, 1, 0); PG8_STAGE(PG8_SA(0, 1), a2 + hstep, voffA);
            PG8_WAIT_V(8); PG8_WAIT_L(0); PG8_BAR; PG8_MMA(0, 0, At, B0); PG8_MMA(0, 1, At, B1); PG8_BAR; PG8_SCHED;
            PG8_LDA(At, 1, 1); PG8_STAGE(PG8_SB(1, 0), b3, voffB); PG8_STAGE(PG8_SB(1, 1), b3 + hstep, voffB); PG8_STAGE(PG8_SA(1, 0), a3, voffA);
            PG8_WAIT_V(8); PG8_WAIT_L(0); PG8_BAR; PG8_MMA(1, 0, At, B0); PG8_MMA(1, 1, At, B1); PG8_BAR; PG8_SCHED;
            } else {
            PG8_LDB(B0, 0, 0); PG8_SCHED; PG8_LDA(At, 0, 0); PG8_STAGE(PG8_SA(1, 1), a1 + hstep, voffA);
            PG8_WAIT_L(8); PG8_BAR; PG8_WAIT_L(0); PG8_MMA(0, 0, At, B0); PG8_BAR; PG8_SCHED;
            PG8_LDB(B1, 0, 1); PG8_STAGE(PG8_SB(0, 0), b2, voffB);
            PG8_BAR; PG8_WAIT_L(0); PG8_MMA(0, 1, At, B1); PG8_BAR;
            PG8_LDA(At, 0, 1); PG8_STAGE(PG8_SA(0, 0), a2, voffA);
            PG8_BAR; PG8_WAIT_L(0); PG8_MMA(1, 0, At, B0); PG8_BAR; PG8_SCHED;
            PG8_STAGE(PG8_SB(0, 1), b2 + hstep, voffB);
            PG8_WAIT_V(6); PG8_BAR; PG8_MMA(1, 1, At, B1); PG8_BAR;
            PG8_LDB(B0, 1, 0); PG8_SCHED; PG8_LDA(At, 1, 0); PG8_STAGE(PG8_SA(0, 1), a2 + hstep, voffA);
            PG8_WAIT_L(8); PG8_BAR; PG8_WAIT_L(0); PG8_MMA(0, 0, At, B0); PG8_BAR; PG8_SCHED;
            PG8_LDB(B1, 1, 1); PG8_STAGE(PG8_SB(1, 0), b3, voffB);
            PG8_BAR; PG8_WAIT_L(0); PG8_MMA(0, 1, At, B1); PG8_BAR;
            PG8_LDA(At, 1, 1); PG8_STAGE(PG8_SA(1, 0), a3, voffA);
            PG8_BAR; PG8_WAIT_L(0); PG8_MMA(1, 0, At, B0); PG8_BAR; PG8_SCHED;
            PG8_STAGE(PG8_SB(1, 1), b3 + hstep, voffB);
            PG8_WAIT_V(6); PG8_BAR; PG8_MMA(1, 1, At, B1); PG8_BAR;
            }
        }
        if constexpr (ALIGN_EPI) { if (wr == 0) PG8_BAR; }
        if constexpr (!Epi::AFTER_DRAIN) { E(acc, cur, wr, wc, fr, fq); S.done(cur); }
        if (!has_next) break;
#pragma unroll
        for (int a = 0; a < 2; ++a)
#pragma unroll
            for (int b = 0; b < 2; ++b)
#pragma unroll
                for (int m = 0; m < 4; ++m)
#pragma unroll
                    for (int n = 0; n < 2; ++n) acc[a][b][m][n] = (f32x4){0.f, 0.f, 0.f, 0.f};
        cur = nxt; cA = nA; cB = nB; ++ui;
        if constexpr (ALIGN_EPI) { if (wr == 1) PG8_BAR; }
    }
    PG8_WAIT_V(0);
    if constexpr (!ALIGN_EPI) { if (wr == 0) PG8_BAR; }
    PG8_BAR;
    if constexpr (Epi::AFTER_DRAIN) { E.fused(acc, cur, wr, wc, fr, fq, lds, wid, lane); S.done(cur); }
#undef PG8_SA
#undef PG8_SB
#undef PG8_STAGE
#undef PG8_LDA
#undef PG8_LDB
#undef PG8_MMA
#undef PG8_WAIT_V
#undef PG8_WAIT_L
#undef PG8_BAR
#undef PG8_SCHED
}
}
#ifndef GEMM_ALIGN
#define GEMM_ALIGN true
#endif
#ifndef GEMM_SP2
#define GEMM_SP2 true
#endif
typedef unsigned short bf16;
typedef float f32x4 __attribute__((ext_vector_type(4)));
typedef float f32x16 __attribute__((ext_vector_type(16)));
typedef short bf16x8 __attribute__((ext_vector_type(8)));
typedef unsigned u32x4 __attribute__((ext_vector_type(4)));
typedef unsigned u32x2 __attribute__((ext_vector_type(2)));
#define LAS __attribute__((address_space(3)))
#define DI __device__ __forceinline__

constexpr int D = 1024, NTOK = 65536, HTOK = 32768, DFF = 2816, NW = 8;
constexpr float EPS = 1e-6f, LOG2E = 1.4426950408889634f;
constexpr size_t MiB = (size_t)1 << 20;
constexpr size_t WS_LB = 0;
constexpr size_t WS_ROPE = 64 * 1024;
constexpr size_t WS_PTR = 512 * 1024;
constexpr size_t WS_BAR = 1 * MiB;
constexpr size_t WS_W1 = 2 * MiB;
constexpr size_t WS_W2 = 90 * MiB;
constexpr size_t WS_HGIN = 134 * MiB;
constexpr size_t WS_HGO = 154 * MiB;
constexpr size_t WS_SWQKV = 158 * MiB;
constexpr size_t WS_SWO = 161 * MiB;
constexpr size_t WS_NAQKV = 163 * MiB;
constexpr size_t WS_NAO = 169 * MiB;
constexpr size_t WS_SSQ = 172 * MiB;
constexpr size_t WS_XN = 176 * MiB;
constexpr size_t WS_AR = 304 * MiB;
constexpr size_t AR_VT = 256 * MiB, AR_OB = 320 * MiB;
constexpr size_t WS_NEED = 704 * MiB;
constexpr int LDS_BYTES = 131072 + 24576;

typedef float f32x2_t __attribute__((ext_vector_type(2))); typedef __bf16 bf16x2_t __attribute__((ext_vector_type(2)));
DI unsigned cvtpk(float lo, float hi) { const f32x2_t v = {lo, hi}; const bf16x2_t b = __builtin_convertvector(v, bf16x2_t); return __builtin_bit_cast(unsigned, b); }
DI float bf2f(unsigned short b) { return __uint_as_float((unsigned)b << 16); }
DI float bflo(unsigned w) { return __uint_as_float(w << 16); }
DI float bfhi(unsigned w) { return __uint_as_float(w & 0xffff0000u); }
DI unsigned short f2bf(float f) { return (unsigned short)(cvtpk(f, 0.f) & 0xffffu); }
DI float h2f(unsigned short h) { return (float)__builtin_bit_cast(_Float16, h); }
DI float wave_sum(float v) {
#pragma unroll
    for (int o = 1; o < 64; o <<= 1) v += __shfl_xor(v, o);
    return v;
}
DI int imin(int a, int b) { return a < b ? a : b; }
DI int imax(int a, int b) { return a > b ? a : b; }
DI int iclamp(int v, int lo, int hi) { return imin(imax(v, lo), hi); }

DI void transpose_item(const float* W, int K, int N, bf16* WT, int item, int lane, bool swiglu, const float* gk) {
    const int nblk = N / 64, kb = item / nblk, nb = item % nblk, k0 = 64 * kb, n0 = 64 * nb;
    int r0 = n0;
    if (swiglu) { r0 = (n0 < DFF) ? (n0 / 128) * 256 + (n0 % 128) : ((n0 - DFF) / 128) * 256 + 128 + ((n0 - DFF) % 128); }
    const float* src = W + (size_t)k0 * N + n0 + lane;
    bf16* dst = WT + (size_t)(r0 + lane) * K + k0;
    float v[64];
#pragma unroll
    for (int j = 0; j < 64; ++j) v[j] = __builtin_nontemporal_load(src + (size_t)j * N);
    if (gk) {
#pragma unroll
        for (int j = 0; j < 64; ++j) v[j] *= gk[k0 + j];
    }
#pragma unroll
    for (int c = 0; c < 8; ++c) { u32x4 o; o.x = cvtpk(v[8 * c], v[8 * c + 1]); o.y = cvtpk(v[8 * c + 2], v[8 * c + 3]); o.z = cvtpk(v[8 * c + 4], v[8 * c + 5]); o.w = cvtpk(v[8 * c + 6], v[8 * c + 7]);
        *(u32x4*)(dst + 8 * c) = o; }
}
struct In { const float *xp, *xs, *norm_g, *fin_g, *w1, *w2, *hg_in, *hg_o, *hg_gn, *hg_lb, *sw_qkv, *sw_o, *sw_sink, *na_qkv, *na_o, *na_rpb; };
struct Args { In in; float* out; unsigned char* ws; double inv[8]; int lo, hi; };

DI void conv_phase(const In& I, unsigned char* ws, const double* inv, unsigned char* lds, int tid) {
    const int lane = tid & 63, wave = tid >> 6;
    const int gw = blockIdx.x * NW + wave, ngw = gridDim.x * NW;
    constexpr int I_W1 = 16 * 88, I_W2 = 44 * 16, I_HGIN = 16 * 80, I_SQ = 16 * 16, I_SWQ = 16 * 24, I_NAQ = 16 * 48;
    constexpr int NIT = 8 * I_W1 + 8 * I_W2 + 2 * I_HGIN + 2 * I_SQ + I_SWQ + I_SQ + I_NAQ + I_SQ;
    for (int it = gw; it < NIT; it += ngw) {
        int r = it;
        if (r < 8 * I_W1) { const int m = r / I_W1; transpose_item(I.w1 + (size_t)m * D * 2 * DFF, D, 2 * DFF, (bf16*)(ws + WS_W1) + (size_t)m * 2 * DFF * D, r % I_W1, lane, true, I.norm_g + ((m >> 1) * 3 + (m & 1) * 2) * D); continue; } r -= 8 * I_W1;
        if (r < 8 * I_W2) { const int m = r / I_W2; transpose_item(I.w2 + (size_t)m * DFF * D, DFF, D, (bf16*)(ws + WS_W2) + (size_t)m * D * DFF, r % I_W2, lane, false, nullptr); continue; } r -= 8 * I_W2;
        if (r < 2 * I_HGIN) { const int m = r / I_HGIN; transpose_item(I.hg_in + (size_t)m * D * 5 * D, D, 5 * D, (bf16*)(ws + WS_HGIN) + (size_t)m * 5 * D * D, r % I_HGIN, lane, false, I.norm_g + (m * 9 + 1) * D); continue; } r -= 2 * I_HGIN;
        if (r < 2 * I_SQ) { const int m = r / I_SQ; transpose_item(I.hg_o + (size_t)m * D * D, D, D, (bf16*)(ws + WS_HGO) + (size_t)m * D * D, r % I_SQ, lane, false, nullptr); continue; } r -= 2 * I_SQ;
        if (r < I_SWQ) { transpose_item(I.sw_qkv, D, 1536, (bf16*)(ws + WS_SWQKV), r, lane, false, I.norm_g + 4 * D); continue; } r -= I_SWQ;
        if (r < I_SQ) { transpose_item(I.sw_o, D, D, (bf16*)(ws + WS_SWO), r, lane, false, nullptr); continue; } r -= I_SQ;
        if (r < I_NAQ) { transpose_item(I.na_qkv, D, 3072, (bf16*)(ws + WS_NAQKV), r, lane, false, I.norm_g + 7 * D); continue; } r -= I_NAQ;
        transpose_item(I.na_o, D, D, (bf16*)(ws + WS_NAO), r, lane, false, nullptr);
    }
    const int gt = blockIdx.x * 512 + tid, ngt = gridDim.x * 512;
    float* lbt = (float*)(ws + WS_LB);
    for (int i = gt; i < 2048; i += ngt) { const int d = i >> 10, c = i & 1023;
        float v[4], mx = -1e30f;
        for (int l = 0; l < 4; ++l) { v[l] = I.hg_lb[(d * 4 + l) * 1024 + c]; mx = fmaxf(mx, v[l]); }
        float s = 0.f; for (int l = 0; l < 4; ++l) { v[l] = __expf(v[l] - mx); s += v[l]; }
        float cum = 0.f; lbt[(0 * 2 + d) * 1024 + c] = 0.f;
        for (int l = 1; l < 4; ++l) { cum += v[l] / s; lbt[(l * 2 + d) * 1024 + c] = cum; } }
    float* rt = (float*)(ws + WS_ROPE);
    for (int i = gt; i < 4096 * 8; i += ngt) { const int pos = i >> 3, j = i & 7;
        const double ang = (double)pos * inv[j]; const double TWO_PI = 6.283185307179586476925;
        const double r = ang - TWO_PI * __builtin_rint(ang / TWO_PI), r2 = r * r;
        double ts = r, sn = r, tc = 1.0, cs = 1.0;
        for (int n = 1; n <= 13; ++n) { ts *= -r2 / (double)((2 * n) * (2 * n + 1)); sn += ts; tc *= -r2 / (double)((2 * n - 1) * (2 * n)); cs += tc; }
        rt[pos * 16 + j] = (float)cs; rt[pos * 16 + 8 + j] = (float)sn; }
}

DI void first_phase(const float* xp, const float* xs, bf16* XB, float* ssq, int tid) {
    const int lane = tid & 63, wave = tid >> 6;
    const int gw = blockIdx.x * NW + wave, ngw = gridDim.x * NW;
    for (int row = gw; row < NTOK; row += ngw) {
        const float* src = row < HTOK ? xp + (size_t)row * D : xs + (size_t)(row - HTOK) * D;
        const f32x4* xr = (const f32x4*)src + lane;
        f32x4 v[4]; float ss = 0.f;
#pragma unroll
        for (int j = 0; j < 4; ++j) { v[j] = __builtin_nontemporal_load(xr + 64 * j); ss += (v[j].x * v[j].x + v[j].y * v[j].y) + (v[j].z * v[j].z + v[j].w * v[j].w); }
        ss = wave_sum(ss);
        u32x2* o = (u32x2*)(XB + (size_t)row * D) + lane;
#pragma unroll
        for (int j = 0; j < 4; ++j) { u32x2 w; w.x = cvtpk(v[j].x, v[j].y); w.y = cvtpk(v[j].z, v[j].w); o[64 * j] = w; }
        if (lane < 16) ssq[(size_t)row * 16 + lane] = (lane == 0) ? ss : 0.f;
    }
}
DI void final_phase(const bf16* XB, const float* ssq, const float* g, float* out, int tid) {
    const int lane = tid & 63, wave = tid >> 6;
    const int gw = blockIdx.x * NW + wave, ngw = gridDim.x * NW;
    f32x4 gv[4];
#pragma unroll
    for (int j = 0; j < 4; ++j) gv[j] = ((const f32x4*)g)[64 * j + lane];
    for (int row = gw; row < NTOK; row += ngw) {
        const float rstd = pg8::rstd_row(ssq, row);
        const u32x2* xr = (const u32x2*)(XB + (size_t)row * D) + lane;
        f32x4* o = (f32x4*)(out + (size_t)row * D) + lane;
#pragma unroll
        for (int j = 0; j < 4; ++j) { const u32x2 w = xr[64 * j]; const f32x4 v = {bflo(w.x), bfhi(w.x), bflo(w.y), bfhi(w.y)}; o[64 * j] = v * rstd * gv[j]; }
    }
}

DI void seq_of(int row, int& base, int& len) { if (row < HTOK) { len = 4096; base = row & ~4095; } else { len = 2048; base = HTOK + ((row - HTOK) & ~2047); } }

DI void rope_phase(bf16* QK, const float* rt, int tid) {
    const int gt = blockIdx.x * 512 + tid, ngt = gridDim.x * 512;
    for (int i = gt; i < NTOK * 20; i += ngt) { const int row = i / 20, hd = i % 20;
        int base, len; seq_of(row, base, len); const int pos = row - base;
        u32x4* p = (u32x4*)(QK + (size_t)row * 1280 + hd * 64);
        const u32x4 a = p[0], b = p[1];
        const f32x4* t = (const f32x4*)(rt + pos * 16); const f32x4 c0 = t[0], c1 = t[1], s0 = t[2], s1 = t[3];
        const float cs[8] = {c0.x, c0.y, c0.z, c0.w, c1.x, c1.y, c1.z, c1.w}, sn[8] = {s0.x, s0.y, s0.z, s0.w, s1.x, s1.y, s1.z, s1.w};
        const unsigned aw[4] = {a.x, a.y, a.z, a.w}, bw[4] = {b.x, b.y, b.z, b.w};
        unsigned oa[4], ob[4];
#pragma unroll
        for (int w = 0; w < 4; ++w) {
            const float x1l = bflo(aw[w]), x1h = bfhi(aw[w]), x2l = bflo(bw[w]), x2h = bfhi(bw[w]);
            oa[w] = cvtpk(x1l * cs[2 * w] - x2l * sn[2 * w], x1h * cs[2 * w + 1] - x2h * sn[2 * w + 1]);
            ob[w] = cvtpk(x2l * cs[2 * w] + x1l * sn[2 * w], x2h * cs[2 * w + 1] + x1h * sn[2 * w + 1]); }
        p[0] = (u32x4){oa[0], oa[1], oa[2], oa[3]}; p[1] = (u32x4){ob[0], ob[1], ob[2], ob[3]};
    }
}

DI int crow(int r, int hi) { return (r & 3) + 8 * (r >> 2) + 4 * hi; }
#define MFMA32(a, b, c) __builtin_amdgcn_mfma_f32_32x32x16_bf16((a), (b), (c), 0, 0, 0)
struct KVFrag { bf16x8 k[4]; bf16x8 v[2][2]; };
DI int kperm(int i) { return (i & 0x13) | ((i & 4) << 1) | ((i & 8) >> 1); }
DI int kidx(int r, int hi) { return (r & 7) + 8 * hi + 16 * (r >> 3); }
DI void kv_load(KVFrag& f, const bf16* Kp  , int ldq, const bf16* Vp  , int tok0, int l32) {
    const bf16* kr = Kp + (size_t)(tok0 + kperm(l32)) * ldq;
#pragma unroll
    for (int s = 0; s < 4; ++s) f.k[s] = *(const bf16x8*)(kr + 16 * s);
#pragma unroll
    for (int dt = 0; dt < 2; ++dt)
#pragma unroll
        for (int ks = 0; ks < 2; ++ks) f.v[dt][ks] = *(const bf16x8*)(Vp + (size_t)dt * 32 * NTOK + tok0 + 16 * ks);
}
template <class F> DI void tile_math(const bf16* Kl, const bf16* Vl, int vs, const F& f, const bf16x8 (&qf)[4], float& m, float& l, f32x16& o0, f32x16& o1, int l32, int hi) {
    bf16x8 kf[4], vf[2][2];
    const bf16* kr = Kl + kperm(l32) * 72 + 8 * hi;
#pragma unroll
    for (int s = 0; s < 4; ++s) kf[s] = *(const bf16x8*)(kr + 16 * s);
#pragma unroll
    for (int dt = 0; dt < 2; ++dt)
#pragma unroll
        for (int ks = 0; ks < 2; ++ks) vf[dt][ks] = *(const bf16x8*)(Vl + (32 * dt + l32) * vs + 16 * ks + 8 * hi);
    f32x16 s = {};
#pragma unroll
    for (int st = 0; st < 4; ++st) s = MFMA32(kf[st], qf[st], s);
    float tmax = -INFINITY;
    if (f.full()) {
#pragma unroll
        for (int r = 0; r < 16; ++r) { s[r] *= (0.125f * LOG2E); tmax = fmaxf(tmax, s[r]); }
    } else {
#pragma unroll
        for (int r = 0; r < 16; ++r) { s[r] = f.score(r, s[r]); tmax = fmaxf(tmax, s[r]); }
    }
    { const auto rr = __builtin_amdgcn_permlane32_swap(__float_as_uint(tmax), __float_as_uint(tmax), false, false); tmax = fmaxf(__uint_as_float(rr[0]), __uint_as_float(rr[1])); }
    if (__ballot(tmax > m + 8.0f) != 0ull) {
        const float mn = fmaxf(m, tmax), fs = __builtin_amdgcn_exp2f(m - mn);
        l *= fs; m = mn;
#pragma unroll
        for (int r = 0; r < 16; ++r) { o0[r] *= fs; o1[r] *= fs; }
    }
    float ps = 0.f;
#pragma unroll
    for (int r = 0; r < 16; ++r) { s[r] = __builtin_amdgcn_exp2f(s[r] - m); ps += s[r]; }
    l += ps;
#pragma unroll
    for (int ks = 0; ks < 2; ++ks) {
        u32x4 pw; pw.x = cvtpk(s[8 * ks], s[8 * ks + 1]); pw.y = cvtpk(s[8 * ks + 2], s[8 * ks + 3]); pw.z = cvtpk(s[8 * ks + 4], s[8 * ks + 5]); pw.w = cvtpk(s[8 * ks + 6], s[8 * ks + 7]);
        const bf16x8 pb = __builtin_bit_cast(bf16x8, pw);
        o0 = MFMA32(vf[0][ks], pb, o0);
        o1 = MFMA32(vf[1][ks], pb, o1);
    }
}
DI void attn_store(bf16* AO, int qtok, int ocol, const f32x16& o0, const f32x16& o1, float l, int hi) {
    l += __shfl_xor(l, 32);
    const float rl = 1.0f / l;
    bf16* op = AO + (size_t)qtok * D + ocol + 4 * hi;
#pragma unroll
    for (int g = 0; g < 4; ++g) {
        u32x2 w0, w1; w0.x = cvtpk(o0[4 * g] * rl, o0[4 * g + 1] * rl); w0.y = cvtpk(o0[4 * g + 2] * rl, o0[4 * g + 3] * rl);
        w1.x = cvtpk(o1[4 * g] * rl, o1[4 * g + 1] * rl); w1.y = cvtpk(o1[4 * g + 2] * rl, o1[4 * g + 3] * rl);
        *(u32x2*)(op + 8 * g) = w0; *(u32x2*)(op + 32 + 8 * g) = w1; }
}
DI u32x4 rope8(u32x4 mine, u32x4 other, const float* cs, bool lo) {
    const f32x4 c0 = *(const f32x4*)cs, c1 = *(const f32x4*)(cs + 4), s0 = *(const f32x4*)(cs + 8), s1 = *(const f32x4*)(cs + 12);
    const float c[8] = {c0.x, c0.y, c0.z, c0.w, c1.x, c1.y, c1.z, c1.w}, s[8] = {s0.x, s0.y, s0.z, s0.w, s1.x, s1.y, s1.z, s1.w};
    const unsigned mw[4] = {mine.x, mine.y, mine.z, mine.w}, ow[4] = {other.x, other.y, other.z, other.w};
    unsigned o[4];
#pragma unroll
    for (int w = 0; w < 4; ++w) {
        const float ml = bflo(mw[w]), mh = bfhi(mw[w]), ol = bflo(ow[w]), oh = bfhi(ow[w]);
        const float sl = lo ? -s[2 * w] : s[2 * w], sh = lo ? -s[2 * w + 1] : s[2 * w + 1];
        o[w] = cvtpk(ml * c[2 * w] + ol * sl, mh * c[2 * w + 1] + oh * sh); }
    return (u32x4){o[0], o[1], o[2], o[3]};
}
DI u32x4 shfl4(u32x4 v, int mask) { return (u32x4){(unsigned)__shfl_xor((int)v.x, mask), (unsigned)__shfl_xor((int)v.y, mask), (unsigned)__shfl_xor((int)v.z, mask), (unsigned)__shfl_xor((int)v.w, mask)}; }
struct SwaF {
    int dbase; bool fullt;
    DI bool full() const { return fullt; }
    DI float score(int r, float raw) const { const int d = dbase + (r & 7) + 16 * (r >> 3); return (d <= 128 && d >= -128) ? raw * (0.125f * LOG2E) : -INFINITY; }
};
DI void swa_phase(const bf16* QK, const bf16* VT, bf16* AO, const float* sinks, const float* rt, unsigned char* lds, int tid) {
    const int lane = tid & 63, wave = tid >> 6, l32 = lane & 31, hi = lane >> 5;
    constexpr int KB = 32 * 72, VS = 40, TB = KB + 64 * VS;
    bf16* T = (bf16*)lds;
    const int qblk = wave >> 2;
    for (int u = blockIdx.x; u < (NTOK / 64) * 4; u += gridDim.x) {
        const int row0 = (u >> 2) * 64, kvh = u & 3, hq = kvh * 4 + (wave & 3);
        int sb, len; seq_of(row0, sb, len); const int q0 = row0 - sb;
        const int t0 = (q0 < 128) ? (128 - q0) / 32 : 0, t1 = imin(9, (len - 1 - (q0 - 128)) / 32);
        const int qtok = row0 + 32 * qblk + l32, qpos = q0 + 32 * qblk + l32;
        bf16x8 qf[4];
        { const bf16* qp = QK + (size_t)qtok * 1280 + hq * 64 + 8 * hi;
#pragma unroll
          for (int s = 0; s < 4; ++s) qf[s] = *(const bf16x8*)(qp + 16 * s); }
        { const u32x4 mine = __builtin_bit_cast(u32x4, qf[0]); qf[0] = __builtin_bit_cast(bf16x8, rope8(mine, shfl4(mine, 32), rt + qpos * 16, hi == 0)); }
        float m = sinks[hq] * LOG2E, l = hi ? 0.f : 1.f; f32x16 o0 = {}, o1 = {};
        const bool isk = tid < 256; const int sr = isk ? (tid >> 3) : ((tid - 256) >> 2), sp = isk ? (tid & 7) : (tid & 3);
        const bf16* gsrc = isk ? QK + (size_t)(sb + q0 - 128 + sr) * 1280 + 1024 + kvh * 64 + sp * 8 : VT + (size_t)(kvh * 64 + sr) * NTOK + (sb + q0 - 128) + sp * 8;
        const size_t gstep = isk ? (size_t)32 * 1280 : 32;
        const int ldst = isk ? sr * 72 + sp * 8 : KB + sr * VS + sp * 8;
#define SWA_ROPE(val, t_) do { if (isk) { const u32x4 oth_ = shfl4(val, 1); if (sp < 2) val = rope8(val, oth_, rt + (q0 - 128 + 32 * (t_) + sr) * 16, sp == 0); } } while (0)
        u32x4 stg = *(const u32x4*)(gsrc + (size_t)t0 * gstep);
        SWA_ROPE(stg, t0);
        *(u32x4*)(T + (t0 & 1) * TB + ldst) = stg;
        if (t0 + 1 <= t1) stg = *(const u32x4*)(gsrc + (size_t)(t0 + 1) * gstep);
        __syncthreads();
        for (int t = t0; t <= t1; ++t) {
            if (t + 1 <= t1) { SWA_ROPE(stg, t + 1); *(u32x4*)(T + ((t + 1) & 1) * TB + ldst) = stg; }
            if (t + 2 <= t1) stg = *(const u32x4*)(gsrc + (size_t)(t + 2) * gstep);
            if (t >= qblk && t <= qblk + 8) {
                SwaF f; f.dbase = (q0 - 128 + 32 * t) + 8 * hi - qpos; { const int rel = 32 * (t - qblk) - 128; f.fullt = (rel >= -96) && (rel <= 96); }
                const bf16* tb = T + (t & 1) * TB;
                tile_math(tb, tb + KB, VS, f, qf, m, l, o0, o1, l32, hi);
            }
            __syncthreads();
        }
        attn_store(AO, qtok, hq * 64, o0, o1, l, hi);
    }
#undef SWA_ROPE
}
struct NaF {
    unsigned colmask; int dcl[16]; int qrow, rsq; const float* rpb; const float* rpt; bool rowok;
    DI bool full() const { return false; }
    DI void tile(int R) { rowok = (R >= rsq) && (R < rsq + 8); rpt = rpb + iclamp(R - qrow + 7, 0, 14) * 32; }
    DI float score(int r, float raw) const { const bool ok = rowok && ((colmask >> r) & 1u); return ok ? fmaf(raw, 0.125f * LOG2E, rpt[dcl[r]]) : -INFINITY; }
};
DI void na_phase(const bf16* QK, const bf16* VT, bf16* AO, const float* rpbg, unsigned char* lds, int tid) {
    const int lane = tid & 63, wave = tid >> 6, l32 = lane & 31, hi = lane >> 5;
    constexpr int KB = 64 * 72, VS = 72, TB = KB + 64 * VS;
    float* rp = (float*)lds;
    bf16* T = (bf16*)(lds + 16 * 15 * 32 * 4);
    for (int i = tid; i < 16 * 15 * 32; i += 512) { const int c = i & 31, hr = i >> 5; rp[i] = (c < 31) ? rpbg[hr * 31 + c] * LOG2E : 0.f; }
    __syncthreads();
    const int rpw = wave >> 2, j = wave & 3;
    for (int u = blockIdx.x; u < 4096; u += gridDim.x) {
        const int g = u >> 4, h = u & 15;
        int rows, seqb, quad;
        if (g < 128) { rows = 64; seqb = (g >> 4) * 4096; quad = g & 15; } else { const int g2 = g - 128; rows = 32; seqb = HTOK + (g2 >> 3) * 2048; quad = g2 & 7; }
        const int r0 = 4 * quad, RA = iclamp(r0 - 4, 0, rows - 8), RB = iclamp(r0 - 1, 0, rows - 8) + 7;
        const int rw = r0 + 2 * rpw, wA = iclamp(rw - 4, 0, rows - 8), wB = iclamp(rw - 3, 0, rows - 8) + 7;
        const int cst = iclamp(16 * j - 8, 0, 32);
        NaF f; f.qrow = rw + (l32 >> 4); const int qcol = 16 * j + (l32 & 15); f.rsq = iclamp(f.qrow - 4, 0, rows - 8); const int csq = iclamp(qcol - 8, 0, 48); f.rpb = rp + h * 15 * 32;
        { unsigned cm = 0u;
#pragma unroll
          for (int r = 0; r < 16; ++r) { const int kc = cst + 8 * hi + (r & 7) + 16 * (r >> 3); cm |= ((kc >= csq) && (kc < csq + 16)) ? (1u << r) : 0u; f.dcl[r] = iclamp(kc - qcol + 15, 0, 30); }
          f.colmask = cm; }
        f.rowok = false; f.rpt = f.rpb;
        const int qtok = seqb + f.qrow * 64 + qcol;
        bf16x8 qf[4];
        { const bf16* qp = QK + (size_t)qtok * 2048 + h * 64 + 8 * hi;
#pragma unroll
          for (int s = 0; s < 4; ++s) qf[s] = *(const bf16x8*)(qp + 16 * s); }
        float m = -1e30f, l = 0.f; f32x16 o0 = {}, o1 = {};
        const int sr = tid >> 3, sp = tid & 7;
        const bf16* gk = QK + (size_t)(seqb + sr) * 2048 + 1024 + h * 64 + sp * 8;
        const bf16* gv = VT + (size_t)(h * 64 + sr) * NTOK + seqb + sp * 8;
        const int lk = sr * 72 + sp * 8, lv = KB + sr * VS + sp * 8;
        u32x4 sk = *(const u32x4*)(gk + (size_t)RA * 64 * 2048), sv = *(const u32x4*)(gv + RA * 64);
        *(u32x4*)(T + (RA & 1) * TB + lk) = sk; *(u32x4*)(T + (RA & 1) * TB + lv) = sv;
        if (RA + 1 <= RB) { sk = *(const u32x4*)(gk + (size_t)(RA + 1) * 64 * 2048); sv = *(const u32x4*)(gv + (RA + 1) * 64); }
        __syncthreads();
        for (int R = RA; R <= RB; ++R) {
            if (R + 1 <= RB) { *(u32x4*)(T + ((R + 1) & 1) * TB + lk) = sk; *(u32x4*)(T + ((R + 1) & 1) * TB + lv) = sv; }
            if (R + 2 <= RB) { sk = *(const u32x4*)(gk + (size_t)(R + 2) * 64 * 2048); sv = *(const u32x4*)(gv + (R + 2) * 64); }
            if (R >= wA && R <= wB) {
                f.tile(R);
                const bf16* tb = T + (R & 1) * TB;
                tile_math(tb + cst * 72, tb + KB + cst, VS, f, qf, m, l, o0, o1, l32, hi);
            }
            __syncthreads();
        }
        attn_store(AO, qtok, h * 64, o0, o1, l, hi);
    }
}

#define MFMA16(a, b, c) __builtin_amdgcn_mfma_f32_16x16x32_bf16((a), (b), (c), 0, 0, 0)
constexpr int SQ = 136, ST = 72;
constexpr int L_QR = 0, L_KR = 17408, L_VRAW = 34816, L_KRT = 52224, L_VT = 70656, L_AM = 89088, L_SPT = 98304, L_SEG = 133120, L_EMID = 137216, L_EEND = 137728;
DI float cexp2(float x) { return __builtin_amdgcn_exp2f(fminf(fmaxf(x, -100.f), 100.f)); }
template <int VS> DI void scan_phase(const bf16* P, bf16* OF, bf16* OB, int half, unsigned char* lds, int tid) {
    constexpr int NVB = VS / 16, VSTR = (VS == 64) ? ST : SQ;
    const int lane = tid & 63, wave = tid >> 6, l16 = lane & 15, rq = lane >> 4;
    const int Tlen = half ? 2048 : 4096, nseq = half ? 16 : 8, NC = Tlen / 64, nitems = nseq * 16 * (128 / VS);
    bf16* QR = (bf16*)(lds + L_QR); bf16* KR = (bf16*)(lds + L_KR); bf16* VRAW = (bf16*)(lds + L_VRAW); bf16* KRT = (bf16*)(lds + L_KRT);
    bf16* VT = (bf16*)(lds + L_VT); bf16* AM = (bf16*)(lds + L_AM); bf16* SPT = (bf16*)(lds + L_SPT);
    float* SEG = (float*)(lds + L_SEG); float* EMID = (float*)(lds + L_EMID); float* EEND = (float*)(lds + L_EEND);
    const int lr = tid >> 3, lc = tid & 7;
    for (int item = blockIdx.x; item < nitems; item += gridDim.x) {
        int vs, dir, h, seq;
        if (VS == 64) { vs = item & 1; dir = (item >> 1) & 1; h = (item >> 2) & 7; seq = item >> 5; } else { vs = 0; dir = item & 1; h = (item >> 1) & 7; seq = item >> 4; }
        const bf16* Pq = P + (size_t)seq * Tlen * 5120 + h * 128;
        const bf16* Pv = Pq + 1024 + vs * VS;
        const bf16* Pl = Pq + 3072 + dir * 1024;
        bf16* Oo = (dir ? OB : OF) + (size_t)seq * Tlen * D + h * 128 + vs * VS;
        f32x4 S[NVB];
#pragma unroll
        for (int i = 0; i < NVB; ++i) S[i] = (f32x4){0.f, 0.f, 0.f, 0.f};
        u32x4 pq0, pq1, pl0, pl1, pv, pv1;
#define SC_TOK(c, tau) (dir ? (Tlen - 1 - ((c) * 64 + (tau))) : ((c) * 64 + (tau)))
#define SC_LOAD(c) do { const size_t ro = (size_t)SC_TOK(c, lr) * 5120; \
            pq0 = *(const u32x4*)(Pq + ro + lc * 8); pq1 = *(const u32x4*)(Pq + ro + 64 + lc * 8); \
            pl0 = *(const u32x4*)(Pl + ro + lc * 8); pl1 = *(const u32x4*)(Pl + ro + 64 + lc * 8); \
            pv = *(const u32x4*)(Pv + ro + lc * 8); if (VS == 128) pv1 = *(const u32x4*)(Pv + ro + 64 + lc * 8); } while (0)
        SC_LOAD(0);
        for (int c = 0; c < NC; ++c) {
            *(u32x4*)(QR + lr * SQ + lc * 8) = pq0; *(u32x4*)(QR + lr * SQ + 64 + lc * 8) = pq1;
            *(u32x4*)(KR + lr * SQ + lc * 8) = pl0; *(u32x4*)(KR + lr * SQ + 64 + lc * 8) = pl1;
            *(u32x4*)(VRAW + lr * VSTR + lc * 8) = pv; if (VS == 128) *(u32x4*)(VRAW + lr * VSTR + 64 + lc * 8) = pv1;
            if (c + 1 < NC) SC_LOAD(c + 1);
            __syncthreads();
            const int kp = tid & 63, seg = tid >> 6;
            unsigned lw[8], qw[8]; float lf0[8], lf1[8], cs0[8], cs1[8]; float run0 = 0.f, run1 = 0.f;
#pragma unroll
            for (int i = 0; i < 8; ++i) lw[i] = *(const unsigned*)(KR + (8 * seg + i) * SQ + 2 * kp);
#pragma unroll
            for (int i = 0; i < 8; ++i) qw[i] = *(const unsigned*)(QR + (8 * seg + i) * SQ + 2 * kp);
#pragma unroll
            for (int i = 0; i < 8; ++i) { lf0[i] = h2f((unsigned short)(lw[i] & 0xffffu)); lf1[i] = h2f((unsigned short)(lw[i] >> 16)); run0 += lf0[i]; run1 += lf1[i]; cs0[i] = run0; cs1[i] = run1; }
            *(f32x2_t*)(SEG + (seg * 64 + kp) * 2) = (f32x2_t){run0, run1};
            { constexpr int NR = VS / 8;
              const int v = tid & (VS - 1), ss = tid / VS; unsigned short t[NR];
#pragma unroll
              for (int i = 0; i < NR; ++i) t[i] = VRAW[(NR * ss + i) * VSTR + v];
#pragma unroll
              for (int j = 0; j < NR / 8; ++j) { u32x4 w; w.x = t[8 * j] | ((unsigned)t[8 * j + 1] << 16); w.y = t[8 * j + 2] | ((unsigned)t[8 * j + 3] << 16); w.z = t[8 * j + 4] | ((unsigned)t[8 * j + 5] << 16); w.w = t[8 * j + 6] | ((unsigned)t[8 * j + 7] << 16);
                  *(u32x4*)(VT + v * ST + NR * ss + 8 * j) = w; } }
            __syncthreads();
            { float pre0 = 0.f, pre1 = 0.f, bm0 = 0.f, bm1 = 0.f, be0 = 0.f, be1 = 0.f;
#pragma unroll
              for (int s = 0; s < 8; ++s) { const f32x2_t t = *(const f32x2_t*)(SEG + (s * 64 + kp) * 2);
                  if (s < seg) { pre0 += t.x; pre1 += t.y; } if (s < 4) { bm0 += t.x; bm1 += t.y; } be0 += t.x; be1 += t.y; }
              float ep0 = cexp2(bm0 - (pre0 + cs0[0] - lf0[0])), ep1 = cexp2(bm1 - (pre1 + cs1[0] - lf1[0]));
              unsigned kw[8];
#pragma unroll
              for (int i = 0; i < 8; ++i) { const int tau = 8 * seg + i;
                  const float e0 = cexp2(bm0 - (pre0 + cs0[i])), e1 = cexp2(bm1 - (pre1 + cs1[i]));
                  *(unsigned*)(QR + tau * SQ + 2 * kp) = cvtpk(bflo(qw[i]) * __builtin_amdgcn_rcpf(e0), bfhi(qw[i]) * __builtin_amdgcn_rcpf(e1));
                  kw[i] = cvtpk(e0 - ep0, e1 - ep1); *(unsigned*)(KR + tau * SQ + 2 * kp) = kw[i]; ep0 = e0; ep1 = e1; }
              u32x4 r0, r1;
              r0.x = (kw[0] & 0xffffu) | (kw[1] << 16); r0.y = (kw[2] & 0xffffu) | (kw[3] << 16); r0.z = (kw[4] & 0xffffu) | (kw[5] << 16); r0.w = (kw[6] & 0xffffu) | (kw[7] << 16);
              r1.x = (kw[0] >> 16) | (kw[1] & 0xffff0000u); r1.y = (kw[2] >> 16) | (kw[3] & 0xffff0000u); r1.z = (kw[4] >> 16) | (kw[5] & 0xffff0000u); r1.w = (kw[6] >> 16) | (kw[7] & 0xffff0000u);
              *(u32x4*)(KRT + (2 * kp) * ST + 8 * seg) = r0; *(u32x4*)(KRT + (2 * kp + 1) * ST + 8 * seg) = r1;
              if (seg == 0) { *(f32x2_t*)(EMID + 2 * kp) = (f32x2_t){cexp2(bm0), cexp2(bm1)}; *(f32x2_t*)(EEND + 2 * kp) = (f32x2_t){cexp2(be0 - bm0), cexp2(be1 - bm1)}; } }
            __syncthreads();
            { const f32x4 em = *(const f32x4*)(EMID + 16 * wave + 4 * rq);
#pragma unroll
              for (int vb = 0; vb < NVB; ++vb) { S[vb] = S[vb] * em; u32x2 w; w.x = cvtpk(S[vb][0], S[vb][1]); w.y = cvtpk(S[vb][2], S[vb][3]);
                  *(u32x2*)(SPT + (16 * vb + l16) * SQ + 16 * wave + 4 * rq) = w; } }
            { const int tb = wave >> 1;
#pragma unroll
              for (int sbi = 0; sbi < 2; ++sbi) { const int sb = 2 * (wave & 1) + sbi; f32x4 acc = {0.f, 0.f, 0.f, 0.f};
                  if (sb <= tb) {
#pragma unroll
                      for (int st = 0; st < 4; ++st) { const bf16x8 a = *(const bf16x8*)(KR + (16 * sb + l16) * SQ + 8 * rq + 32 * st), b = *(const bf16x8*)(QR + (16 * tb + l16) * SQ + 8 * rq + 32 * st); acc = MFMA16(a, b, acc); }
                      const int t = 16 * tb + l16, s0 = 16 * sb + 4 * rq;
#pragma unroll
                      for (int r = 0; r < 4; ++r) acc[r] = (s0 + r <= t) ? acc[r] : 0.f;
                  }
                  u32x2 w; w.x = cvtpk(acc[0], acc[1]); w.y = cvtpk(acc[2], acc[3]);
                  *(u32x2*)(AM + (16 * tb + l16) * ST + 16 * sb + 4 * rq) = w; } }
            __syncthreads();
            { const int tb = wave >> 1; const size_t orow = (size_t)SC_TOK(c, 16 * tb + l16) * D;
#pragma unroll
              for (int vbi = 0; vbi < NVB / 2; ++vbi) { const int vb = (NVB / 2) * (wave & 1) + vbi; f32x4 acc = {0.f, 0.f, 0.f, 0.f};
#pragma unroll
                  for (int st = 0; st < 4; ++st) { const bf16x8 a = *(const bf16x8*)(SPT + (16 * vb + l16) * SQ + 8 * rq + 32 * st), b = *(const bf16x8*)(QR + (16 * tb + l16) * SQ + 8 * rq + 32 * st); acc = MFMA16(a, b, acc); }
#pragma unroll
                  for (int st = 0; st < 2; ++st) { const bf16x8 a = *(const bf16x8*)(VT + (16 * vb + l16) * ST + 8 * rq + 32 * st), b = *(const bf16x8*)(AM + (16 * tb + l16) * ST + 8 * rq + 32 * st); acc = MFMA16(a, b, acc); }
                  u32x2 w; w.x = cvtpk(acc[0], acc[1]); w.y = cvtpk(acc[2], acc[3]);
                  *(u32x2*)(Oo + orow + 16 * vb + 4 * rq) = w; } }
            { const bf16x8 a0 = *(const bf16x8*)(KRT + (16 * wave + l16) * ST + 8 * rq), a1 = *(const bf16x8*)(KRT + (16 * wave + l16) * ST + 8 * rq + 32);
              const f32x4 ee = *(const f32x4*)(EEND + 16 * wave + 4 * rq);
#pragma unroll
              for (int vb = 0; vb < NVB; ++vb) { const bf16x8 b0 = *(const bf16x8*)(VT + (16 * vb + l16) * ST + 8 * rq), b1 = *(const bf16x8*)(VT + (16 * vb + l16) * ST + 8 * rq + 32);
                  S[vb] = MFMA16(a0, b0, S[vb]); S[vb] = MFMA16(a1, b1, S[vb]); S[vb] = S[vb] * ee; } }
            __syncthreads();
        }
#undef SC_LOAD
#undef SC_TOK
    }
}
DI void combine_phase(const bf16* OF, const bf16* OB, const bf16* P, const float* gn, bf16* AOh, int tid) {
    const int lane = tid & 63, wave = tid >> 6, gw = blockIdx.x * NW + wave, ngw = gridDim.x * NW;
    float gv[16];
#pragma unroll
    for (int i = 0; i < 16; ++i) gv[i] = gn[16 * lane + i];
    for (int row = gw; row < HTOK; row += ngw) {
        const u32x4* pf = (const u32x4*)(OF + (size_t)row * D + 16 * lane); const u32x4* pb = (const u32x4*)(OB + (size_t)row * D + 16 * lane);
        const u32x4* pg = (const u32x4*)(P + (size_t)row * 5120 + 2048 + 16 * lane);
        const u32x4 f0 = pf[0], f1 = pf[1], b0 = pb[0], b1 = pb[1], g0 = pg[0], g1 = pg[1];
        const unsigned fw[8] = {f0.x, f0.y, f0.z, f0.w, f1.x, f1.y, f1.z, f1.w}, bw[8] = {b0.x, b0.y, b0.z, b0.w, b1.x, b1.y, b1.z, b1.w}, gw8[8] = {g0.x, g0.y, g0.z, g0.w, g1.x, g1.y, g1.z, g1.w};
        float o[16]; float ss = 0.f;
#pragma unroll
        for (int i = 0; i < 8; ++i) { o[2 * i] = bflo(fw[i]) + bflo(bw[i]); o[2 * i + 1] = bfhi(fw[i]) + bfhi(bw[i]); ss += o[2 * i] * o[2 * i] + o[2 * i + 1] * o[2 * i + 1]; }
        ss += __shfl_xor(ss, 1); ss += __shfl_xor(ss, 2); ss += __shfl_xor(ss, 4);
        const float rstd = 1.0f / sqrtf(ss * (1.0f / 128.0f) + EPS);
        unsigned ow[8];
#pragma unroll
        for (int i = 0; i < 8; ++i) { const float ga = bflo(gw8[i]), gb = bfhi(gw8[i]);
            const float ya = o[2 * i] * rstd * gv[2 * i] * (ga * pg8::fast_sigmoid(ga)), yb = o[2 * i + 1] * rstd * gv[2 * i + 1] * (gb * pg8::fast_sigmoid(gb));
            ow[i] = cvtpk(ya, yb); }
        u32x4* po = (u32x4*)(AOh + (size_t)row * D + 16 * lane);
        po[0] = (u32x4){ow[0], ow[1], ow[2], ow[3]}; po[1] = (u32x4){ow[4], ow[5], ow[6], ow[7]};
    }
}

#define XB_TMO      128
#define XB_XCNT(j)  (256  + 64 * (j))
#define XB_XSUB(j)  (1280 + 64 * (j))
#define XB_XGEN(j)  (2304 + 64 * (j))
#define XB_TOP      3328
#define XB_TOPGEN   3392
#define XCD_BAR_WORDS 3456
#define XB_SPIN_CAP (1u << 18)

__device__ __forceinline__ unsigned xb_ld(unsigned* p)              { return __hip_atomic_load(p, __ATOMIC_RELAXED, __HIP_MEMORY_SCOPE_AGENT); }
__device__ __forceinline__ unsigned xb_add(unsigned* p, unsigned v) { return __hip_atomic_fetch_add(p, v, __ATOMIC_RELAXED, __HIP_MEMORY_SCOPE_AGENT); }
__device__ __forceinline__ unsigned xb_xcc_id() { return (unsigned)__builtin_amdgcn_s_getreg((3 << 11) | 20) & 0xFu; }
#define XB_SPIN(cond, bar) do { unsigned _sp = 0; while (cond) { __builtin_amdgcn_s_sleep(1); \
    if ((++_sp & 255u) == 0u) { if (xb_ld(&(bar)[XB_TMO])) break; if (_sp > XB_SPIN_CAP) { atomicAdd(&(bar)[XB_TMO], 1u); break; } } } } while (0)

struct XcdBarrier {
    unsigned* bar; unsigned x;
    volatile LAS unsigned* st;
};

__device__ __forceinline__ XcdBarrier xcd_barrier_post(unsigned* bar, volatile LAS unsigned* st) {
    XcdBarrier b; b.bar = bar; b.x = xb_xcc_id(); b.st = st;
    if (threadIdx.x == 0) (void)xb_add(&bar[XB_XCNT(b.x)], 1u);
    return b;
}
__device__ __forceinline__ void xcd_barrier_complete(unsigned* bar, unsigned x, unsigned& nloc, unsigned& nx) {
    const unsigned G = gridDim.x * gridDim.y * gridDim.z;
    unsigned sum, cnt, mine, sp = 0u;
    for (;;) {
        sum = 0u; cnt = 0u; mine = 0u;
#pragma unroll
        for (unsigned j = 0; j < 16; ++j) { const unsigned c = xb_ld(&bar[XB_XCNT(j)]); sum += c; cnt += (c > 0u) ? 1u : 0u; mine = (j == x) ? c : mine; }
        if (sum == G) break;
        __builtin_amdgcn_s_sleep(1);
        if ((++sp & 255u) == 0u) { if (xb_ld(&bar[XB_TMO])) break; if (sp > XB_SPIN_CAP) { atomicAdd(&bar[XB_TMO], 1u); break; } }
    }
    nloc = mine > 0u ? mine : 1u; nx = cnt > 0u ? cnt : 1u;
}

__device__ __forceinline__ void xcd_barrier(const XcdBarrier& b) {
    asm volatile("s_waitcnt vmcnt(0)" ::: "memory");
    __syncthreads();
    if (threadIdx.x == 0) {
        unsigned* bar = b.bar;
        __builtin_amdgcn_s_waitcnt(0);
        unsigned nloc = b.st[0], nx = b.st[1];
        if (nloc == 0u) { xcd_barrier_complete(bar, b.x, nloc, nx); b.st[0] = nloc; b.st[1] = nx; }
        const unsigned old = xb_add(&bar[XB_XSUB(b.x)], 1u);
        const unsigned gen = old / nloc;
        if (old + 1u == (gen + 1u) * nloc) {
            __builtin_amdgcn_fence(__ATOMIC_RELEASE, "agent");
            asm volatile("s_waitcnt vmcnt(0)" ::: "memory");
            const unsigned og = xb_add(&bar[XB_TOP], 1u);
            const unsigned tg = og / nx;
            if (og + 1u == (tg + 1u) * nx) xb_add(&bar[XB_TOPGEN], 1u);
            else XB_SPIN(xb_ld(&bar[XB_TOPGEN]) == tg, bar);
            __builtin_amdgcn_fence(__ATOMIC_ACQUIRE, "agent");
            xb_add(&bar[XB_XGEN(b.x)], 1u);
            asm volatile("s_waitcnt vmcnt(0)" ::: "memory");
        } else {
            XB_SPIN(xb_ld(&bar[XB_XGEN(b.x)]) == gen, bar);
            __builtin_amdgcn_fence(__ATOMIC_ACQUIRE, "agent");
            asm volatile("s_waitcnt vmcnt(0)" ::: "memory");
        }
    }
    __syncthreads();
}

template <bool COLS> DI const float* prep_rstd(unsigned char* lds, const float* ssq, int M, int N, int tid) {
    float* tab = (float*)(lds + 131072); int* list = (int*)(lds + 131072 + 23552);
    int bx = blockIdx.x; asm volatile("" : "+s"(bx));
    pg8::StaticOrder S; S.init(M, N, (int)gridDim.x, bx); pg8::Unit u;
    int n = 0;
    for (int i = 0; S.next(i, u); ++i) { if (tid == 0) list[i] = COLS ? u.pn : u.pm; ++n; }
    __syncthreads();
#pragma unroll 4
    for (int e = tid; e < n * 256; e += 512) tab[e] = pg8::rstd_row(ssq, list[e >> 8] * 256 + (e & 255));
    __syncthreads();
    return tab;
}
DI void stagger(int slots, int ticks) {
    const int k = (int)(blockIdx.x >> 3) % slots;
    if (k) { const unsigned long long t0 = __builtin_amdgcn_s_memrealtime(); while (__builtin_amdgcn_s_memrealtime() - t0 < (unsigned long long)(k * ticks)) __builtin_amdgcn_s_sleep(8); }
}
template <class Epi> DI void run_gemm(unsigned char* lds, const bf16* A, const bf16* Bt, int M, int N, int K, const Epi& E, int tid) {
    int bx = blockIdx.x; asm volatile("" : "+s"(bx));
    pg8::Gemm g{A, Bt, M, N, K}; pg8::StaticOrder S; S.init(M, N, (int)gridDim.x, bx);
    pg8::gemm_phase<Epi, pg8::StaticOrder, GEMM_ALIGN, GEMM_SP2>((LAS unsigned char*)lds, g, S, E, tid);
    __syncthreads();
}

__global__ void __launch_bounds__(512, 2) fwd(Args a) {
    extern __shared__ __attribute__((aligned(16))) unsigned char lds[];
    cg::grid_group grid = cg::this_grid();
    volatile LAS unsigned* bst = (volatile LAS unsigned*)((LAS unsigned char*)lds + LDS_BYTES - 16);
    if (threadIdx.x < 2) bst[threadIdx.x] = 0u;
    __syncthreads();
    const XcdBarrier xbar = xcd_barrier_post((unsigned*)(a.ws + WS_BAR), bst);
    unsigned char* ws0 = a.ws;
    const In& I = a.in;
    const int lo = a.lo, hi = a.hi;
    int pc = 0;
#ifndef REP_NORM
#define REP_NORM 1
#endif
#ifndef REP_SCAN
#define REP_SCAN 1
#endif
#ifndef REP_ATTN
#define REP_ATTN 1
#endif
#ifndef REP_FFN1
#define REP_FFN1 1
#endif
#define PTR(k) (((const float* const*)(ws + WS_PTR))[k])
#ifndef STAG_SLOTS
#define STAG_SLOTS 1
#endif
#ifndef STAG_TICKS
#define STAG_TICKS 800
#endif
#ifndef REP_FFN2
#define REP_FFN2 1
#endif
#ifndef REP_HG
#define REP_HG 1
#endif
#ifndef GEMM_SP2
#define GEMM_SP2 true
#endif
#ifndef REP_MISC
#define REP_MISC 1
#endif
#ifndef REP_WO
#define REP_WO 1
#endif
#ifndef REP_SYNC
#define REP_SYNC 1
#endif
#define PH_BEGIN if (pc >= lo && pc < hi) { int tid = threadIdx.x; asm volatile("" : "+v"(tid)); unsigned char* ws = ws0; asm volatile("" : "+s"(ws)); bf16* XB = (bf16*)(ws + WS_XN); bf16* AR = (bf16*)(ws + WS_AR); float* SSQ = (float*)(ws + WS_SSQ); bf16* AO = AO0; asm volatile("" : "+s"(AO)); bf16* OF = AO + (size_t)NTOK * D; bf16* OB = OF + (size_t)HTOK * D; bf16* VT = (bf16*)(ws + WS_AR + AR_VT);
#define PH_END if (pc + 1 < hi) { for (int rs_ = 0; rs_ < REP_SYNC; ++rs_) { if (lo < 0) grid.sync(); else xcd_barrier(xbar); }     } } ++pc;

    bf16* AO0 = (bf16*)a.out;
    PH_BEGIN if (blockIdx.x == 0 && tid == 0) { const float** pt = (const float**)(ws + WS_PTR); pt[0] = I.hg_gn; pt[1] = I.sw_sink; pt[2] = I.na_rpb; pt[3] = I.fin_g; }
             for (int rp_ = 0; rp_ < REP_MISC; ++rp_) { conv_phase(I, ws, a.inv, lds, tid); first_phase(I.xp, I.xs, XB, SSQ, tid); } PH_END
    for (int li = 0; li < 4; ++li) {
        for (int sub = 0; sub < 3; ++sub) {
            if (sub != 1) {
                const int fi = li * 2 + (sub >> 1);
                #ifdef SPLIT_FFN1
                PH_BEGIN for (int hh_ = 0; hh_ < 2; ++hh_) { pg8::EpiSwiglu E{AR + (size_t)hh_ * HTOK * DFF, DFF, prep_rstd<false>(lds, SSQ + (size_t)hh_ * HTOK * 16, HTOK, 2 * DFF, tid)}; run_gemm(lds, XB + (size_t)hh_ * HTOK * D, (const bf16*)(ws + WS_W1) + (size_t)fi * 2 * DFF * D, HTOK, 2 * DFF, D, E, tid); if (hh_ == 0) xcd_barrier(xbar); } PH_END
#else
                PH_BEGIN for (int rp_ = 0; rp_ < REP_FFN1; ++rp_) { pg8::EpiSwiglu E{AR, DFF, prep_rstd<false>(lds, SSQ, NTOK, 2 * DFF, tid)}; run_gemm(lds, XB, (const bf16*)(ws + WS_W1) + (size_t)fi * 2 * DFF * D, NTOK, 2 * DFF, D, E, tid); } PH_END
#endif
                PH_BEGIN for (int rp_ = 0; rp_ < REP_FFN2; ++rp_) { pg8::EpiResid E{XB, (rp_ == REP_FFN2 - 1) ? 0.5f : 0.0f, SSQ}; run_gemm(lds, AR, (const bf16*)(ws + WS_W2) + (size_t)fi * D * DFF, NTOK, D, DFF, E, tid); } PH_END
            } else {
                const int kind = li % 3;
                if (kind == 0) {
                    const int ia = li / 3;
                    for (int half = 0; half < 2; ++half) {
                        PH_BEGIN for (int rp_ = 0; rp_ < REP_HG; ++rp_) { pg8::EpiHg E{AR, (const float*)(ws + WS_LB) + li * 2048, prep_rstd<false>(lds, SSQ + (size_t)half * HTOK * 16, HTOK, 5 * D, tid)}; run_gemm(lds, XB + (size_t)half * HTOK * D, (const bf16*)(ws + WS_HGIN) + (size_t)ia * 5 * D * D, HTOK, 5 * D, D, E, tid); } PH_END
                        PH_BEGIN for (int rp_ = 0; rp_ < REP_SCAN; ++rp_) { if (half == 0) scan_phase<64>(AR, OF, OB, 0, lds, tid); else scan_phase<128>(AR, OF, OB, 1, lds, tid); } PH_END
                        PH_BEGIN for (int rp_ = 0; rp_ < REP_MISC; ++rp_) combine_phase(OF, OB, AR, PTR(0) + ia * D, AO + (size_t)half * HTOK * D, tid); PH_END
                    }
                    PH_BEGIN for (int rp_ = 0; rp_ < REP_WO; ++rp_) { pg8::EpiResid E{XB, (rp_ == REP_WO - 1) ? 1.0f : 0.0f, SSQ}; run_gemm(lds, AO, (const bf16*)(ws + WS_HGO) + (size_t)ia * D * D, NTOK, D, D, E, tid); } PH_END
                } else if (kind == 1) {
                    PH_BEGIN { pg8::EpiStore<false> E{AR, 1280, prep_rstd<false>(lds, SSQ, NTOK, 1280, tid)}; run_gemm(lds, XB, (const bf16*)(ws + WS_SWQKV), NTOK, 1280, D, E, tid); }
                             { pg8::EpiStore<true> E{VT, NTOK, prep_rstd<true>(lds, SSQ, 256, NTOK, tid)}; run_gemm(lds, (const bf16*)(ws + WS_SWQKV) + (size_t)1280 * D, XB, 256, NTOK, D, E, tid); } PH_END
                    PH_BEGIN for (int rp_ = 0; rp_ < REP_ATTN; ++rp_) swa_phase(AR, VT, AO, PTR(1), (const float*)(ws + WS_ROPE), lds, tid); PH_END
                    PH_BEGIN for (int rp_ = 0; rp_ < REP_WO; ++rp_) { pg8::EpiResid E{XB, (rp_ == REP_WO - 1) ? 1.0f : 0.0f, SSQ}; run_gemm(lds, AO, (const bf16*)(ws + WS_SWO), NTOK, D, D, E, tid); } PH_END
                } else {
                    PH_BEGIN { pg8::EpiStore<false> E{AR, 2048, prep_rstd<false>(lds, SSQ, NTOK, 2048, tid)}; run_gemm(lds, XB, (const bf16*)(ws + WS_NAQKV), NTOK, 2048, D, E, tid); }
                             { pg8::EpiStore<true> E{VT, NTOK, prep_rstd<true>(lds, SSQ, D, NTOK, tid)}; run_gemm(lds, (const bf16*)(ws + WS_NAQKV) + (size_t)2048 * D, XB, D, NTOK, D, E, tid); } PH_END
                    PH_BEGIN for (int rp_ = 0; rp_ < REP_ATTN; ++rp_) na_phase(AR, VT, AO, PTR(2), lds, tid); PH_END
                    PH_BEGIN for (int rp_ = 0; rp_ < REP_WO; ++rp_) { pg8::EpiResid E{XB, (rp_ == REP_WO - 1) ? 1.0f : 0.0f, SSQ}; run_gemm(lds, AO, (const bf16*)(ws + WS_NAO), NTOK, D, D, E, tid); } PH_END
                }
            }
        }
    }
    PH_BEGIN for (int rp_ = 0; rp_ < REP_MISC; ++rp_) final_phase(XB, SSQ, PTR(3), (float*)AO, tid); PH_END
}
constexpr int NPHASES = 1 + 4 * 4 + (7 + 3 + 3 + 7) + 1;

#ifndef MULTI_LAUNCH
#define MULTI_LAUNCH 0
#endif
extern "C" void kernel_launch(void* const* d_in, const int* in_sizes, int n_in, void* d_out, int out_size, void* d_ws, size_t ws_size, hipStream_t stream) {
    static int grid = 0;
    if (grid == 0) {
        if (n_in != 16 || out_size != NTOK * D || ws_size < WS_NEED) { fprintf(stderr, "kernel_launch: unexpected shapes (n_in %d out %d ws %zu)\n", n_in, out_size, ws_size); grid = -1; return; }
        int dev = 0, cus = 0, per_cu = 0;
        hipGetDevice(&dev); hipDeviceGetAttribute(&cus, hipDeviceAttributeMultiprocessorCount, dev);
        if (hipFuncSetAttribute((const void*)fwd, hipFuncAttributeMaxDynamicSharedMemorySize, LDS_BYTES) != hipSuccess) { fprintf(stderr, "kernel_launch: hipFuncSetAttribute failed\n"); grid = -1; return; }
        if (hipOccupancyMaxActiveBlocksPerMultiprocessor(&per_cu, (const void*)fwd, 512, LDS_BYTES) != hipSuccess || per_cu < 1) { fprintf(stderr, "kernel_launch: occupancy query says %d\n", per_cu); per_cu = 1; }
        (void)hipGetLastError();
        grid = cus * per_cu;
    }
    if (grid < 0) return;
    Args a; memset(&a, 0, sizeof(a));
    const float** ip = (const float**)&a.in;
    for (int i = 0; i < 16; ++i) ip[i] = (const float*)d_in[i];
    a.out = (float*)d_out; a.ws = (unsigned char*)d_ws;
    for (int j = 0; j < 8; ++j) a.inv[j] = exp(-(double)j * (2.0 / 16.0) * log(500000.0));
#if MULTI_LAUNCH
    for (int p = 0; p < NPHASES; ++p) { a.lo = p; a.hi = p + 1; hipLaunchKernelGGL(fwd, dim3(grid), dim3(512), LDS_BYTES, stream, a); }
#else
    a.lo = 0; a.hi = NPHASES;
    (void)hipMemsetAsync((unsigned char*)d_ws + WS_BAR, 0, 16384, stream);
    void* args[] = {&a};
    hipError_t e = hipLaunchCooperativeKernel((const void*)fwd, dim3(grid), dim3(512), args, LDS_BYTES, stream);
    if (e != hipSuccess) fprintf(stderr, "cooperative launch failed: %s (grid %d)\n", hipGetErrorString(e), grid);
#endif
}
```
